# Optimizing an MI355X kernel written in HIP

```python
import jax, jax.numpy as jnp
from jax import lax
import numpy as np

D_MODEL = 1024
BATCH = 32
SEQ = 256
DEPTH = 1
DEC_BATCH = 8
DEC_SEQ = 4096
PAST_LEN = 512

GRID_W = 64
HEAD_DIM = 64
A_HEADS = 8
A_KV_HEADS = 2
B_HEADS = 8
A_WIDTH = A_HEADS * HEAD_DIM
A_KV_WIDTH = A_KV_HEADS * HEAD_DIM
B_WIDTH = B_HEADS * HEAD_DIM
D_FF = 4 * D_MODEL
WIN_H = 8
WIN_W = 16
Q_BLOCK = 128
ROPE_BASE = 10000.0
ROPE_PAIRS = HEAD_DIM // 4
RMS_EPS = 1e-6
N_MOD = 6
IN_SPLITS = (A_WIDTH, A_KV_WIDTH, A_KV_WIDTH, B_WIDTH, B_WIDTH, B_WIDTH, D_MODEL, D_MODEL)
IN_WIDTH = sum(IN_SPLITS)
SPLIT_POINTS = tuple(int(i) for i in np.cumsum(IN_SPLITS)[:-1])
NEG_INF = -1e30

kernel_name = 'hybrid_dit_gqa_natten_prefix_step'


def _rmsnorm(x, g):
    xf = x.astype(jnp.float32)
    inv = lax.rsqrt(jnp.mean(xf * xf, axis=-1, keepdims=True) + RMS_EPS)
    return (xf * inv).astype(x.dtype) * g


def _modulation(cvec, w_mod, b_mod):
    m = jax.nn.silu(cvec) @ w_mod + b_mod
    return jnp.split(m[:, None, :], N_MOD, axis=-1)


def _axial_rope_tables(t):
    pos = jnp.arange(t, dtype=jnp.int32)
    row = (pos // GRID_W).astype(jnp.float32)
    col = (pos % GRID_W).astype(jnp.float32)
    inv = ROPE_BASE ** (-jnp.arange(ROPE_PAIRS, dtype=jnp.float32) / ROPE_PAIRS)
    ang_r = row[:, None] * inv
    ang_c = col[:, None] * inv
    return jnp.cos(ang_r), jnp.sin(ang_r), jnp.cos(ang_c), jnp.sin(ang_c)


def _rot(x, cos, sin):
    cos = cos[None, :, None, :].astype(x.dtype)
    sin = sin[None, :, None, :].astype(x.dtype)
    x1, x2 = x[..., :ROPE_PAIRS], x[..., ROPE_PAIRS:]
    return jnp.concatenate([x1 * cos - x2 * sin, x1 * sin + x2 * cos], axis=-1)


def _axial_rope(x, tables):
    cr, sr, cc, sc = tables
    half = HEAD_DIM // 2
    return jnp.concatenate([_rot(x[..., :half], cr, sr), _rot(x[..., half:], cc, sc)], axis=-1)


def _block_attention(q, k, v):
    b, t, h, dh = q.shape
    kv = k.shape[2]
    rep = h // kv
    nb = t // Q_BLOCK
    qb = q.reshape(b, nb, Q_BLOCK, kv, rep, dh).transpose(1, 0, 2, 3, 4, 5)
    scale = dh ** -0.5

    def one(qblk):
        s = jnp.einsum('bqgrd,bkgd->bgrqk', qblk, k).astype(jnp.float32) * scale
        p = jax.nn.softmax(s, axis=-1).astype(v.dtype)
        return jnp.einsum('bgrqk,bkgd->bqgrd', p, v)

    o = lax.map(one, qb)
    return o.transpose(1, 0, 2, 3, 4, 5).reshape(b, t, h * dh)


def _neighbourhood_attention(q, k, v, ctx_k, ctx_v, rel_bias):
    b, t, h, dh = q.shape
    rows = t // GRID_W
    wh = min(WIN_H, rows)
    ww = WIN_W
    scale = dh ** -0.5
    qg = q.reshape(b, rows, GRID_W, h, dh)
    kg = k.reshape(b, rows, GRID_W, h, dh)
    vg = v.reshape(b, rows, GRID_W, h, dh)
    col = jnp.arange(GRID_W, dtype=jnp.int32)
    cstart = jnp.clip(col - ww // 2, 0, GRID_W - ww)
    col_mask = (col[None, :] >= cstart[:, None]) & (col[None, :] < cstart[:, None] + ww)
    dc_idx = jnp.clip(col[None, :] - col[:, None] + WIN_W - 1, 0, 2 * WIN_W - 2)
    n_loc = wh * GRID_W

    def row_block(r):
        rs = jnp.clip(r - wh // 2, 0, rows - wh)
        kr = lax.dynamic_slice_in_dim(kg, rs, wh, axis=1)
        vr = lax.dynamic_slice_in_dim(vg, rs, wh, axis=1)
        qr = lax.dynamic_index_in_dim(qg, r, axis=1, keepdims=False)
        s_loc = jnp.einsum('bqhd,bnkhd->bhqnk', qr, kr).astype(jnp.float32) * scale
        dr_idx = rs + jnp.arange(wh, dtype=jnp.int32) - r + WIN_H - 1
        bias = rel_bias[:, dr_idx[None, :, None], dc_idx[:, None, :]].astype(jnp.float32)
        s_loc = jnp.where(col_mask[:, None, :], s_loc + bias[None], NEG_INF).reshape(b, h, GRID_W, n_loc)
        s_ctx = jnp.einsum('bqhd,bkhd->bhqk', qr, ctx_k).astype(jnp.float32) * scale
        p = jax.nn.softmax(jnp.concatenate([s_loc, s_ctx], axis=-1), axis=-1).astype(v.dtype)
        o = jnp.einsum('bhqn,bnhd->bqhd', p[..., :n_loc], vr.reshape(b, n_loc, h, dh))
        return o + jnp.einsum('bhqk,bkhd->bqhd', p[..., n_loc:], ctx_v)

    o = lax.map(row_block, jnp.arange(rows, dtype=jnp.int32))
    return o.transpose(1, 0, 2, 3, 4).reshape(b, t, h * dh)


def _mixer_inputs(h, w_in, q_norm_g, k_norm_g):
    b, t, _ = h.shape
    aq, ak, av, bq, bk, bv, ga, gb = jnp.split(h @ w_in, SPLIT_POINTS, axis=-1)
    aq = _rmsnorm(aq.reshape(b, t, A_HEADS, HEAD_DIM), q_norm_g)
    ak = _rmsnorm(ak.reshape(b, t, A_KV_HEADS, HEAD_DIM), k_norm_g)
    av = av.reshape(b, t, A_KV_HEADS, HEAD_DIM)
    bq = bq.reshape(b, t, B_HEADS, HEAD_DIM)
    bk = bk.reshape(b, t, B_HEADS, HEAD_DIM)
    bv = bv.reshape(b, t, B_HEADS, HEAD_DIM)
    return aq, ak, av, bq, bk, bv, ga, gb


def _merge(a_o, b_o, ga, gb, w_br_a, w_br_b, w_out):
    m = jax.nn.sigmoid(ga) * (a_o @ w_br_a) + jax.nn.sigmoid(gb) * (b_o @ w_br_b)
    return m @ w_out


def _mlp(h, w_mlp_in, w_mlp_out):
    return jnp.square(jax.nn.relu(h @ w_mlp_in)) @ w_mlp_out


def _context_layer(x, c_ctx, lp):
    (w_mod, b_mod, n1, n2, w_in, qg, kg, nat_bias, w_br_a, w_br_b, w_out, w1, w2) = lp
    sh1, sc1, g1, sh2, sc2, g2 = _modulation(c_ctx[None, :], w_mod, b_mod)
    h = _rmsnorm(x, n1) * (1 + sc1) + sh1
    aq, ak, av, bq, bk, bv, ga, gb = _mixer_inputs(h, w_in, qg, kg)
    a_o = _block_attention(aq, ak, av)
    b_o = _block_attention(bq, bk, bv)
    x = x + g1 * _merge(a_o, b_o, ga, gb, w_br_a, w_br_b, w_out)
    h2 = _rmsnorm(x, n2) * (1 + sc2) + sh2
    x = x + g2 * _mlp(h2, w1, w2)
    return x, (ak, av, bk, bv)


def _latent_layer(x, c, ctx_ak, ctx_av, ctx_bk, ctx_bv, lp):
    (w_mod, b_mod, n1, n2, w_in, qg, kg, nat_bias, w_br_a, w_br_b, w_out, w1, w2) = lp
    t = x.shape[1]
    sh1, sc1, g1, sh2, sc2, g2 = _modulation(c, w_mod, b_mod)
    h = _rmsnorm(x, n1) * (1 + sc1) + sh1
    aq, ak, av, bq, bk, bv, ga, gb = _mixer_inputs(h, w_in, qg, kg)
    tables = _axial_rope_tables(t)
    aq = _axial_rope(aq, tables)
    ak = _axial_rope(ak, tables)
    a_o = _block_attention(aq, jnp.concatenate([ctx_ak, ak], axis=1), jnp.concatenate([ctx_av, av], axis=1))
    b_o = _neighbourhood_attention(bq, bk, bv, ctx_bk, ctx_bv, nat_bias)
    x = x + g1 * _merge(a_o, b_o, ga, gb, w_br_a, w_br_b, w_out)
    h2 = _rmsnorm(x, n2) * (1 + sc2) + sh2
    return x + g2 * _mlp(h2, w1, w2)


def setup_inputs(seed: int = 0) -> dict:
    key = jax.random.key(seed)
    ks = jax.random.split(key, 24)
    nrm = jax.random.normal
    f32 = jnp.float32
    d = D_MODEL
    return {
        'x_prompt': nrm(ks[0], (BATCH, SEQ, d), f32),
        'x_sample': nrm(ks[1], (DEC_BATCH, DEC_SEQ, d), f32),
        'cache_a_k': nrm(ks[2], (DEC_BATCH, DEPTH, PAST_LEN, A_KV_HEADS, HEAD_DIM), f32),
        'cache_a_v': nrm(ks[3], (DEC_BATCH, DEPTH, PAST_LEN, A_KV_HEADS, HEAD_DIM), f32),
        'cache_b_k': nrm(ks[4], (DEC_BATCH, DEPTH, PAST_LEN, B_HEADS, HEAD_DIM), f32),
        'cache_b_v': nrm(ks[5], (DEC_BATCH, DEPTH, PAST_LEN, B_HEADS, HEAD_DIM), f32),
        'c': nrm(ks[6], (DEC_BATCH, d), f32),
        'c_ctx': nrm(ks[7], (d,), f32),
        'w_mod': nrm(ks[8], (DEPTH, d, N_MOD * d), f32) * (0.5 * d ** -0.5),
        'b_mod': nrm(ks[9], (DEPTH, N_MOD * d), f32) * 0.01,
        'norm1_g': 1.0 + 0.01 * nrm(ks[10], (DEPTH, d), f32),
        'norm2_g': 1.0 + 0.01 * nrm(ks[11], (DEPTH, d), f32),
        'w_in': nrm(ks[12], (DEPTH, d, IN_WIDTH), f32) * d ** -0.5,
        'q_norm_g': 1.0 + 0.01 * nrm(ks[13], (DEPTH, HEAD_DIM), f32),
        'k_norm_g': 1.0 + 0.01 * nrm(ks[14], (DEPTH, HEAD_DIM), f32),
        'nat_bias': nrm(ks[15], (DEPTH, B_HEADS, 2 * WIN_H - 1, 2 * WIN_W - 1), f32) * 0.1,
        'w_br_a': nrm(ks[16], (DEPTH, A_WIDTH, d), f32) * A_WIDTH ** -0.5,
        'w_br_b': nrm(ks[17], (DEPTH, B_WIDTH, d), f32) * B_WIDTH ** -0.5,
        'w_out': nrm(ks[18], (DEPTH, d, d), f32) * d ** -0.5,
        'w_mlp_in': nrm(ks[19], (DEPTH, d, D_FF), f32) * d ** -0.5,
        'w_mlp_out': nrm(ks[20], (DEPTH, D_FF, d), f32) * D_FF ** -0.5,
        'final_norm_g': 1.0 + 0.01 * nrm(ks[21], (d,), f32),
    }


def reference(x_prompt, x_sample, cache_a_k, cache_a_v, cache_b_k, cache_b_v, c, c_ctx,
              w_mod, b_mod, norm1_g, norm2_g, w_in, q_norm_g, k_norm_g, nat_bias,
              w_br_a, w_br_b, w_out, w_mlp_in, w_mlp_out, final_norm_g):
    xp = x_prompt
    xs = x_sample
    ak_l, av_l, bk_l, bv_l = [], [], [], []
    for l in range(DEPTH):
        lp = (w_mod[l], b_mod[l], norm1_g[l], norm2_g[l], w_in[l], q_norm_g[l], k_norm_g[l],
              nat_bias[l], w_br_a[l], w_br_b[l], w_out[l], w_mlp_in[l], w_mlp_out[l])
        xp, (ak, av, bk, bv) = _context_layer(xp, c_ctx, lp)
        ak_l.append(ak)
        av_l.append(av)
        bk_l.append(bk)
        bv_l.append(bv)
        xs = _latent_layer(xs, c, cache_a_k[:, l], cache_a_v[:, l], cache_b_k[:, l], cache_b_v[:, l], lp)
    y_prompt = _rmsnorm(xp, final_norm_g)
    y_sample = _rmsnorm(xs, final_norm_g)
    new_a_k = jnp.stack(ak_l, axis=1)
    new_a_v = jnp.stack(av_l, axis=1)
    new_b_k = jnp.stack(bk_l, axis=1)
    new_b_v = jnp.stack(bv_l, axis=1)
    return (y_prompt, y_sample, new_a_k, new_a_v, new_b_k, new_b_v)
```

```cpp
#include <hip/hip_runtime.h>
#include <hip/hip_cooperative_groups.h>
#include <hip/hip_bf16.h>
#include <cstdio>
#include <cstdint>
#include <cmath>
namespace cg = cooperative_groups;

#ifndef MK_PER_PHASE
#define MK_PER_PHASE 0
#endif

#define LAS __attribute__((address_space(3)))
#define GAS __attribute__((address_space(1)))
typedef unsigned short bf16_t;
typedef short bf16x8 __attribute__((ext_vector_type(8)));
typedef float f32x4 __attribute__((ext_vector_type(4)));
typedef float f32x2 __attribute__((ext_vector_type(2)));
typedef unsigned u32x4 __attribute__((ext_vector_type(4)));
typedef unsigned u32x2 __attribute__((ext_vector_type(2)));

constexpr int DM = 1024, NBP = 32, SEQP = 256, NBS = 8, SEQS = 4096, PAST = 512;
constexpr int MP = NBP * SEQP, MS = NBS * SEQS, M = MP + MS;
constexpr int NIN = 4352, FF = 4096, NMOD = 6 * DM;
constexpr int KVL = PAST + SEQS;
constexpr int KVROWS = NBS * KVL + MP;
constexpr float RMS_EPS = 1e-6f;
constexpr float LOG2E = 1.4426950408889634f;
constexpr float C2 = 0.125f * LOG2E;
constexpr size_t OUT_Y = 0, OUT_AK = (size_t)M * DM, OUT_AV = OUT_AK + (size_t)MP * 128, OUT_BK = OUT_AV + (size_t)MP * 128, OUT_BV = OUT_BK + (size_t)MP * 512;
constexpr size_t MiB = 1u << 20;
constexpr size_t WS_MOD = 0, WS_BUP = 256 * 1024, WS_ROPE = 512 * 1024, WS_SSQ = 1 * MiB;
constexpr size_t WS_WIN = 4 * MiB, WS_WBRA = 13 * MiB, WS_WBRB = 14 * MiB, WS_WOUT = 15 * MiB, WS_W1 = 17 * MiB, WS_W2 = 25 * MiB;
constexpr size_t WS_H = 34 * MiB, WS_QA = 114 * MiB, WS_QB = 154 * MiB, WS_KA = 194 * MiB, WS_VA = 205 * MiB, WS_KB = 216 * MiB, WS_VB = 260 * MiB;
constexpr size_t WS_GA = 304 * MiB, WS_GB = 384 * MiB, WS_XW = 432 * MiB, WS_HID = 34 * MiB, WS_MM = 34 * MiB, WS_END = 512 * MiB;
static_assert(WS_WIN + (size_t)NIN * DM * 2 <= WS_WBRA && WS_W2 + (size_t)DM * FF * 2 <= WS_H && WS_KA + (size_t)KVROWS * 128 * 2 <= WS_VA && WS_KB + (size_t)KVROWS * 512 * 2 <= WS_VB, "ws map");
static_assert(WS_VB + (size_t)KVROWS * 512 * 2 <= WS_GA && WS_GB + (size_t)M * DM * 2 <= WS_END && WS_HID + (size_t)M * FF * 2 <= WS_XW && WS_XW + (size_t)M * DM * 2 <= WS_END, "ws map 2");
static_assert(WS_SSQ + (size_t)M * 16 * 4 <= WS_WIN, "ws map 3");

__device__ __forceinline__ unsigned cvt_pk_bf16(float lo, float hi) { unsigned r; asm volatile("v_cvt_pk_bf16_f32 %0, %1, %2" : "=v"(r) : "v"(lo), "v"(hi)); return r; }
__device__ __forceinline__ float bf_lo(unsigned w) { return __uint_as_float(w << 16); }
__device__ __forceinline__ float bf_hi(unsigned w) { return __uint_as_float(w & 0xffff0000u); }
__device__ __forceinline__ float wave_sum(float v) {
#pragma unroll
    for (int o = 1; o < 64; o <<= 1) v += __shfl_xor(v, o);
    return v;
}
__device__ __forceinline__ float sigmoidf_(float x) { return 1.0f / (1.0f + __expf(-x)); }

namespace pg8 {
constexpr int BM = 256, BK = 64, HALF = 128, HTB = HALF * BK * 2, STAGE_BYTES = 8 * HTB, NXCD = 8, WGM = 8;
__host__ __device__ __forceinline__ int lds_byte(int r, int c) { const int st = (r >> 4) * 2 + (c >> 5), rr = r & 15, cc = c & 31, ob = rr * 64 + cc * 2; return st * 1024 + (ob ^ (((ob >> 9) & 1) << 5)); }
__host__ __device__ __forceinline__ void stage_rc(int b, int& R, int& C) { const int st = b / 1024, sb = b % 1024, swz = sb ^ (((sb >> 9) & 1) << 5); R = (st >> 1) * 16 + swz / 64; C = (st & 1) * 32 + (swz % 64) / 2; }
__host__ __device__ __forceinline__ int perm32(int rho) { const int n = rho >> 4, i = rho & 15; return 8 * (i >> 2) + 4 * n + (i & 3); }

struct Unit { int pm, pn, s; };

struct StaticOrder {
    int nM, nN, nwg, G, c;
    __device__ __forceinline__ void init(int M_, int N_, int G_, int c_) { nM = M_ / BM; nN = N_ / BM; nwg = nM * nN; G = G_; c = c_; }
    __device__ __forceinline__ bool next(int i, Unit& u) const {
        const long L = (long)i * G + c; if (L >= nwg) return false;
        int wgid = (int)L; { const int q = nwg / NXCD, r = nwg % NXCD, xcd = wgid % NXCD, off = wgid / NXCD; wgid = (xcd < r ? xcd * (q + 1) : r * (q + 1) + (xcd - r) * q) + off; }
        const int nig = WGM * nN, gid = wgid / nig, fm = gid * WGM, gsz = (nM - fm) < WGM ? (nM - fm) : WGM;
        u.pm = fm + ((wgid % nig) % gsz); u.pn = (wgid % nig) / gsz; u.s = 0; return true;
    }
};
struct PairOrder : StaticOrder {
    __device__ __forceinline__ bool next(int i, Unit& u) const { const bool ok = StaticOrder::next(i >> 1, u); u.s = i & 1; return ok; }
};

template <class Epi, class Sched, class Ops>
__device__ __forceinline__ void gemm_phase(LAS unsigned char* lds, const Ops& P, const int K, const Sched& S, const Epi& E) {
    int tid = threadIdx.x; asm volatile("" : "+v"(tid));
    const int wid = __builtin_amdgcn_readfirstlane(tid >> 6), lane = tid & 63, wr = wid >> 2, wc = wid & 3, fr = lane & 15, fq = lane >> 4;
    const int nt = K / BK;
    unsigned voffA[2], voffB[2];
#pragma unroll
    for (int i = 0; i < 2; ++i) { int R, C; stage_rc(tid * 16 + i * 8192, R, C); const int Rb = Epi::PERM ? ((R & ~31) + perm32(R & 31)) : R;
        voffA[i] = (unsigned)(R * K + C) * 2u; voffB[i] = (unsigned)(Rb * K + C) * 2u; }
    const size_t kstep = (size_t)(BK * 2);
    const size_t hstep = (size_t)HALF * K * 2;
    const unsigned ldsw = (unsigned)wid * 1024u;
    const int aoff = lds_byte(wr * 64 + fr, fq * 8), boff = lds_byte(wc * 32 + fr, fq * 8);
#define PG8_SA(b, h) (((b) * 2 + (h)) * HTB)
#define PG8_SB(b, h) ((4 + (b) * 2 + (h)) * HTB)
#define PG8_STAGE(bufoff, gbase, voff) do { _Pragma("unroll") for (int _i = 0; _i < 2; ++_i) \
        __builtin_amdgcn_global_load_lds((const unsigned*)((const char*)(gbase) + (voff)[_i]), (LAS unsigned*)(lds + (bufoff) + ldsw + _i * 8192), 16, 0, 0); } while (0)
#define PG8_LDA(dst, b, h) do { _Pragma("unroll") for (int m = 0; m < 4; ++m) _Pragma("unroll") for (int k = 0; k < 2; ++k) dst[m][k] = *(const LAS bf16x8*)(lds + PG8_SA(b, h) + aoff + m * 2048 + k * 1024); } while (0)
#define PG8_LDB(dst, b, h) do { _Pragma("unroll") for (int n = 0; n < 2; ++n) _Pragma("unroll") for (int k = 0; k < 2; ++k) dst[n][k] = *(const LAS bf16x8*)(lds + PG8_SB(b, h) + boff + n * 2048 + k * 1024); } while (0)
#define PG8_MMA(ai, bj, At, Bt) do { __builtin_amdgcn_s_setprio(1); _Pragma("unroll") for (int m = 0; m < 4; ++m) _Pragma("unroll") for (int n = 0; n < 2; ++n) _Pragma("unroll") for (int k = 0; k < 2; ++k) \
        acc[ai][bj][m][n] = __builtin_amdgcn_mfma_f32_16x16x32_bf16(Bt[n][k], At[m][k], acc[ai][bj][m][n], 0, 0, 0); __builtin_amdgcn_s_setprio(0); } while (0)
#define PG8_WAIT_V(n) asm volatile("s_waitcnt vmcnt(" #n ")" ::: "memory")
#define PG8_WAIT_L(n) asm volatile("s_waitcnt lgkmcnt(" #n ")" ::: "memory")
#define PG8_BAR __builtin_amdgcn_s_barrier()
#define PG8_SCHED __builtin_amdgcn_sched_barrier(0)
    Unit cur, nxt; int ui = 0;
    if (!S.next(0, cur)) return;
    f32x4 acc[2][2][4][2];
#pragma unroll
    for (int a = 0; a < 2; ++a)
#pragma unroll
        for (int b = 0; b < 2; ++b)
#pragma unroll
            for (int m = 0; m < 4; ++m)
#pragma unroll
                for (int n = 0; n < 2; ++n) acc[a][b][m][n] = (f32x4){0.f, 0.f, 0.f, 0.f};
    bf16x8 At[4][2], B0[2][2], B1[2][2];
    const char* cA = P.a_base(cur); const char* cB = P.b_base(cur);
    PG8_STAGE(PG8_SB(0, 0), cB, voffB); PG8_STAGE(PG8_SB(0, 1), cB + hstep, voffB); PG8_STAGE(PG8_SA(0, 0), cA, voffA); PG8_STAGE(PG8_SA(0, 1), cA + hstep, voffA);
    if (wr == 1) PG8_BAR;
    PG8_WAIT_V(2); PG8_BAR;
    PG8_STAGE(PG8_SB(1, 0), cB + kstep, voffB); PG8_STAGE(PG8_SA(1, 0), cA + kstep, voffA); PG8_STAGE(PG8_SB(1, 1), cB + hstep + kstep, voffB);
    PG8_WAIT_V(6); PG8_BAR;
    for (;;) {
        const bool has_next = S.next(ui + 1, nxt);
        const char* nA = has_next ? P.a_base(nxt) : cA; const char* nB = has_next ? P.b_base(nxt) : cB;
        for (int t = 0; t < nt; t += 2) {
            const bool last = (t == nt - 2);
            const char* a1 = cA + (size_t)(t + 1) * kstep;
            const char* a2 = last ? nA : cA + (size_t)(t + 2) * kstep; const char* b2 = last ? nB : cB + (size_t)(t + 2) * kstep;
            const char* a3 = a2 + kstep; const char* b3 = b2 + kstep;
            PG8_LDB(B0, 0, 0); PG8_LDB(B1, 0, 1); PG8_SCHED; PG8_LDA(At, 0, 0); PG8_STAGE(PG8_SA(1, 1), a1 + hstep, voffA);
            PG8_WAIT_V(8); PG8_WAIT_L(0); PG8_BAR; PG8_MMA(0, 0, At, B0); PG8_MMA(0, 1, At, B1); PG8_BAR; PG8_SCHED;
            PG8_LDA(At, 0, 1); PG8_STAGE(PG8_SB(0, 0), b2, voffB); PG8_STAGE(PG8_SB(0, 1), b2 + hstep, voffB); PG8_STAGE(PG8_SA(0, 0), a2, voffA);
            PG8_WAIT_V(8); PG8_WAIT_L(0); PG8_BAR; PG8_MMA(1, 0, At, B0); PG8_MMA(1, 1, At, B1); PG8_BAR; PG8_SCHED;
            PG8_LDB(B0, 1, 0); PG8_LDB(B1, 1, 1); PG8_SCHED; PG8_LDA(At, 1, 0); PG8_STAGE(PG8_SA(0, 1), a2 + hstep, voffA);
            PG8_WAIT_V(8); PG8_WAIT_L(0); PG8_BAR; PG8_MMA(0, 0, At, B0); PG8_MMA(0, 1, At, B1); PG8_BAR; PG8_SCHED;
            PG8_LDA(At, 1, 1); PG8_STAGE(PG8_SB(1, 0), b3, voffB); PG8_STAGE(PG8_SB(1, 1), b3 + hstep, voffB); PG8_STAGE(PG8_SA(1, 0), a3, voffA);
            PG8_WAIT_V(8); PG8_WAIT_L(0); PG8_BAR; PG8_MMA(1, 0, At, B0); PG8_MMA(1, 1, At, B1); PG8_BAR; PG8_SCHED;
        }
        if (wr == 0) PG8_BAR;
        E(acc, cur, wr, wc, fr, fq);
        if (!has_next) break;
        if (!E.keep(cur)) {
#pragma unroll
            for (int a = 0; a < 2; ++a)
#pragma unroll
                for (int b = 0; b < 2; ++b)
#pragma unroll
                    for (int m = 0; m < 4; ++m)
#pragma unroll
                        for (int n = 0; n < 2; ++n) acc[a][b][m][n] = (f32x4){0.f, 0.f, 0.f, 0.f};
        }
        cur = nxt; cA = nA; cB = nB; ++ui;
        if (wr == 1) PG8_BAR;
    }
    PG8_WAIT_V(0);
    PG8_BAR;
#undef PG8_SA
#undef PG8_SB
#undef PG8_STAGE
#undef PG8_LDA
#undef PG8_LDB
#undef PG8_MMA
#undef PG8_WAIT_V
#undef PG8_WAIT_L
#undef PG8_BAR
#undef PG8_SCHED
}
}

struct OpsPlain { const char* A; const char* Bt; size_t tstep;
    __device__ __forceinline__ const char* a_base(const pg8::Unit& u) const { return A + (size_t)u.pm * tstep; }
    __device__ __forceinline__ const char* b_base(const pg8::Unit& u) const { return Bt + (size_t)u.pn * tstep; } };
struct OpsPair { const char* A0; long dA; const char* B0; long dB; size_t tstep;
    __device__ __forceinline__ const char* a_base(const pg8::Unit& u) const { return A0 + (long)u.s * dA + (size_t)u.pm * tstep; }
    __device__ __forceinline__ const char* b_base(const pg8::Unit& u) const { return B0 + (long)u.s * dB + (size_t)u.pn * tstep; } };


struct EpiIn {
    static constexpr bool PERM = true;
    unsigned char* ws; float* out; const float *qg, *kg;
    __device__ __forceinline__ bool keep(const pg8::Unit&) const { return false; }
    __device__ __forceinline__ void operator()(f32x4 (&acc)[2][2][4][2], const pg8::Unit& u, int wr, int wc, int fr, int fq) const {
        const int pn = u.pn, pm = u.pm; const bool prompt = pm < 32;
        int kind, hcol;
        if (pn < 2) { kind = 0; hcol = (4 * pn + wc) * 64; }
        else if (pn == 2) { if (wc < 2) { kind = 1; hcol = wc * 64; } else { kind = 2; hcol = (wc - 2) * 64; } }
        else if (pn < 5) { kind = 3; hcol = (4 * (pn - 3) + wc) * 64; }
        else if (pn < 7) { kind = 4; hcol = (4 * (pn - 5) + wc) * 64; }
        else if (pn < 9) { kind = 5; hcol = (4 * (pn - 7) + wc) * 64; }
        else if (pn < 13) { kind = 6; hcol = 256 * (pn - 9) + 64 * wc; }
        else { kind = 7; hcol = 256 * (pn - 13) + 64 * wc; }
        bf16_t* dst; int pitch; float* fo = nullptr; bool kvdst = false;
        switch (kind) {
            case 0: dst = (bf16_t*)(ws + WS_QA); pitch = 512; break;
            case 1: dst = (bf16_t*)(ws + WS_KA); pitch = 128; kvdst = true; fo = out + OUT_AK; break;
            case 2: dst = (bf16_t*)(ws + WS_VA); pitch = 128; kvdst = true; fo = out + OUT_AV; break;
            case 3: dst = (bf16_t*)(ws + WS_QB); pitch = 512; break;
            case 4: dst = (bf16_t*)(ws + WS_KB); pitch = 512; kvdst = true; fo = out + OUT_BK; break;
            case 5: dst = (bf16_t*)(ws + WS_VB); pitch = 512; kvdst = true; fo = out + OUT_BV; break;
            case 6: dst = (bf16_t*)(ws + WS_GA); pitch = 1024; break;
            default: dst = (bf16_t*)(ws + WS_GB); pitch = 1024; break;
        }
        const float* ropec = (const float*)(ws + WS_ROPE); const float* ropes = ropec + 1024;
        const bool norm = kind <= 1, rope = norm && !prompt;
        const float qscale = (kind == 0 || kind == 3) ? C2 : 1.0f;
        const int lb = prompt ? 0 : ((pm - 32) >> 4), tb = prompt ? 0 : ((pm - 32) & 15);
        const long rowadd = kvdst ? (prompt ? (long)NBS * KVL : (long)(-MP) + 512L * (lb + 1)) : 0L;
        const float* gsel = ((kind == 0) ? qg : kg) + 8 * fq;
        const int i0 = 8 * (fq & 1);
#pragma unroll
        for (int ai = 0; ai < 2; ++ai) {
            const int grow = 4 * tb + 2 * ai + wr;
#pragma unroll
            for (int m = 0; m < 4; ++m) {
                const int rt = ai * 128 + wr * 64 + m * 16 + fr; const long row = (long)pm * 256 + rt;
                f32x4 v[2][2];
#pragma unroll
                for (int bj = 0; bj < 2; ++bj)
#pragma unroll
                    for (int n = 0; n < 2; ++n) v[bj][n] = acc[ai][bj][m][n];
                if (norm) {
                    float ss = 0.f;
#pragma unroll
                    for (int bj = 0; bj < 2; ++bj)
#pragma unroll
                        for (int n = 0; n < 2; ++n) ss += (v[bj][n][0] * v[bj][n][0] + v[bj][n][1] * v[bj][n][1]) + (v[bj][n][2] * v[bj][n][2] + v[bj][n][3] * v[bj][n][3]);
                    ss += __shfl_xor(ss, 16); ss += __shfl_xor(ss, 32);
                    const float inv = 1.0f / sqrtf(ss * (1.0f / 64.0f) + RMS_EPS);
#pragma unroll
                    for (int bj = 0; bj < 2; ++bj)
#pragma unroll
                        for (int n = 0; n < 2; ++n) v[bj][n] = (v[bj][n] * inv) * *(const f32x4*)(gsel + 32 * bj + 4 * n);
                }
                if (fo && prompt) {
                    float* fp = fo + (size_t)row * pitch + hcol + 8 * fq;
#pragma unroll
                    for (int bj = 0; bj < 2; ++bj)
#pragma unroll
                        for (int n = 0; n < 2; ++n) *(f32x4*)(fp + 32 * bj + 4 * n) = v[bj][n];
                }
                if (rope) {
                    const int gcol = m * 16 + fr;
#pragma unroll
                    for (int bj = 0; bj < 2; ++bj) {
                        const float* tc = ropec + (bj ? gcol : grow) * 16 + i0; const float* ts = ropes + (bj ? gcol : grow) * 16 + i0;
#pragma unroll
                        for (int n = 0; n < 2; ++n) {
                            const f32x4 co = *(const f32x4*)(tc + 4 * n), si = *(const f32x4*)(ts + 4 * n);
                            f32x4 o;
#pragma unroll
                            for (int e = 0; e < 4; ++e) { const float mine = v[bj][n][e], oth = __shfl_xor(mine, 32);
                                o[e] = (fq < 2) ? (mine * co[e] - oth * si[e]) : (oth * si[e] + mine * co[e]); }
                            v[bj][n] = o;
                        }
                    }
                }
                bf16_t* dp = dst + (size_t)(row + rowadd) * pitch + hcol + 8 * fq;
#pragma unroll
                for (int bj = 0; bj < 2; ++bj) {
                    f32x4 a = v[bj][0], b = v[bj][1];
                    if (kind >= 6) {
#pragma unroll
                        for (int e = 0; e < 4; ++e) { a[e] = sigmoidf_(a[e]); b[e] = sigmoidf_(b[e]); }
                    } else { a = a * qscale; b = b * qscale; }
                    u32x4 w; w.x = cvt_pk_bf16(a[0], a[1]); w.y = cvt_pk_bf16(a[2], a[3]); w.z = cvt_pk_bf16(b[0], b[1]); w.w = cvt_pk_bf16(b[2], b[3]);
                    *(u32x4*)(dp + 32 * bj) = w;
                }
                asm volatile("" ::: "memory");
            }
        }
    }
};

struct EpiBr {
    static constexpr bool PERM = true;
    const bf16_t *GA, *GB; bf16_t* MMo;
    __device__ __forceinline__ bool keep(const pg8::Unit& u) const { return u.s == 0; }
    __device__ __forceinline__ void operator()(f32x4 (&acc)[2][2][4][2], const pg8::Unit& u, int wr, int wc, int fr, int fq) const {
        const int col0 = u.pn * 256 + wc * 32 + 8 * fq;
#pragma unroll
        for (int ai = 0; ai < 2; ++ai)
#pragma unroll
            for (int m = 0; m < 4; ++m) { const size_t row = (size_t)u.pm * 256 + ai * 128 + wr * 64 + m * 16 + fr;
#pragma unroll
                for (int bj = 0; bj < 2; ++bj) { const size_t off = row * 1024 + col0 + bj * 128;
                    const u32x4 gb = *(const u32x4*)(GB + off);
                    const f32x4 sb0 = {bf_lo(gb.x), bf_hi(gb.x), bf_lo(gb.y), bf_hi(gb.y)}, sb1 = {bf_lo(gb.z), bf_hi(gb.z), bf_lo(gb.w), bf_hi(gb.w)};
                    if (u.s == 0) {
                        const u32x4 ga = *(const u32x4*)(GA + off);
                        const f32x4 sa0 = {bf_lo(ga.x), bf_hi(ga.x), bf_lo(ga.y), bf_hi(ga.y)}, sa1 = {bf_lo(ga.z), bf_hi(ga.z), bf_lo(ga.w), bf_hi(ga.w)};
                        acc[ai][bj][m][0] = acc[ai][bj][m][0] * (sa0 / sb0); acc[ai][bj][m][1] = acc[ai][bj][m][1] * (sa1 / sb1);
                    } else {
                        const f32x4 o0 = acc[ai][bj][m][0] * sb0, o1 = acc[ai][bj][m][1] * sb1;
                        u32x4 w; w.x = cvt_pk_bf16(o0[0], o0[1]); w.y = cvt_pk_bf16(o0[2], o0[3]); w.z = cvt_pk_bf16(o1[0], o1[1]); w.w = cvt_pk_bf16(o1[2], o1[3]);
                        *(u32x4*)(MMo + off) = w;
                    }
                }
                asm volatile("" ::: "memory"); }
    }
};

struct EpiOut {
    static constexpr bool PERM = false;
    const float *xp, *xs, *mod, *n2; float* x1; bf16_t* XW; float* ssq;
    __device__ __forceinline__ bool keep(const pg8::Unit&) const { return false; }
    __device__ __forceinline__ void operator()(f32x4 (&acc)[2][2][4][2], const pg8::Unit& u, int wr, int wc, int fr, int fq) const {
        const int pm = u.pm; const bool prompt = pm < 32; const int mrow = prompt ? 8 : ((pm - 32) >> 4);
        const float* modr = mod + (size_t)mrow * NMOD; const int col0 = u.pn * 256 + wc * 32 + 4 * fq;
        const float* xbase = prompt ? xp : (xs - (size_t)MP * DM);
        f32x4 g1[2][2], w2[2][2];
#pragma unroll
        for (int bj = 0; bj < 2; ++bj)
#pragma unroll
            for (int n = 0; n < 2; ++n) { const int c = col0 + bj * 128 + n * 16; g1[bj][n] = *(const f32x4*)(modr + 2048 + c);
                const f32x4 sc = *(const f32x4*)(modr + 4096 + c), nn = *(const f32x4*)(n2 + c); w2[bj][n] = nn * (sc + 1.0f); }
#pragma unroll
        for (int ai = 0; ai < 2; ++ai)
#pragma unroll
            for (int m = 0; m < 4; ++m) { const size_t row = (size_t)pm * 256 + ai * 128 + wr * 64 + m * 16 + fr; float ss = 0.f;
#pragma unroll
                for (int bj = 0; bj < 2; ++bj)
#pragma unroll
                    for (int n = 0; n < 2; ++n) { const size_t off = row * DM + col0 + bj * 128 + n * 16;
                        const f32x4 xv = *(const f32x4*)(xbase + off); const f32x4 o = xv + g1[bj][n] * acc[ai][bj][m][n];
                        *(f32x4*)(x1 + off) = o; ss += (o[0] * o[0] + o[1] * o[1]) + (o[2] * o[2] + o[3] * o[3]);
                        const f32x4 ow = o * w2[bj][n]; u32x2 w; w.x = cvt_pk_bf16(ow[0], ow[1]); w.y = cvt_pk_bf16(ow[2], ow[3]); *(u32x2*)(XW + off) = w; }
                ss += __shfl_xor(ss, 16); ss += __shfl_xor(ss, 32);
                if (fq == 0) ssq[row * 16 + u.pn * 4 + wc] = ss; }
    }
};

struct EpiUp {
    static constexpr bool PERM = true;
    const float *ssq, *bup; bf16_t* HID;
    __device__ __forceinline__ bool keep(const pg8::Unit&) const { return false; }
    __device__ __forceinline__ void operator()(f32x4 (&acc)[2][2][4][2], const pg8::Unit& u, int wr, int wc, int fr, int fq) const {
        const int pm = u.pm; const int mrow = pm < 32 ? 8 : ((pm - 32) >> 4); const int col0 = u.pn * 256 + wc * 32 + 8 * fq;
        f32x4 bv[2][2];
#pragma unroll
        for (int bj = 0; bj < 2; ++bj)
#pragma unroll
            for (int n = 0; n < 2; ++n) bv[bj][n] = *(const f32x4*)(bup + (size_t)mrow * FF + col0 + bj * 128 + 4 * n);
#pragma unroll
        for (int ai = 0; ai < 2; ++ai)
#pragma unroll
            for (int m = 0; m < 4; ++m) { const size_t row = (size_t)pm * 256 + ai * 128 + wr * 64 + m * 16 + fr;
                const f32x4* sp = (const f32x4*)(ssq + row * 16); const f32x4 s0 = sp[0], s1 = sp[1], s2 = sp[2], s3 = sp[3];
                const float tot = (((s0[0] + s0[1]) + (s0[2] + s0[3])) + ((s1[0] + s1[1]) + (s1[2] + s1[3]))) + (((s2[0] + s2[1]) + (s2[2] + s2[3])) + ((s3[0] + s3[1]) + (s3[2] + s3[3])));
                const float inv = 1.0f / sqrtf(tot * (1.0f / DM) + RMS_EPS);
#pragma unroll
                for (int bj = 0; bj < 2; ++bj) { f32x4 a = acc[ai][bj][m][0] * inv + bv[bj][0], b = acc[ai][bj][m][1] * inv + bv[bj][1];
#pragma unroll
                    for (int e = 0; e < 4; ++e) { a[e] = fmaxf(a[e], 0.f); a[e] *= a[e]; b[e] = fmaxf(b[e], 0.f); b[e] *= b[e]; }
                    u32x4 w; w.x = cvt_pk_bf16(a[0], a[1]); w.y = cvt_pk_bf16(a[2], a[3]); w.z = cvt_pk_bf16(b[0], b[1]); w.w = cvt_pk_bf16(b[2], b[3]);
                    *(u32x4*)(HID + row * FF + col0 + bj * 128) = w; } }
    }
};

struct EpiDown {
    static constexpr bool PERM = false;
    const float* mod; float* x1;
    __device__ __forceinline__ bool keep(const pg8::Unit&) const { return false; }
    __device__ __forceinline__ void operator()(f32x4 (&acc)[2][2][4][2], const pg8::Unit& u, int wr, int wc, int fr, int fq) const {
        const int pm = u.pm; const int mrow = pm < 32 ? 8 : ((pm - 32) >> 4); const float* modr = mod + (size_t)mrow * NMOD; const int col0 = u.pn * 256 + wc * 32 + 4 * fq;
        f32x4 g2[2][2];
#pragma unroll
        for (int bj = 0; bj < 2; ++bj)
#pragma unroll
            for (int n = 0; n < 2; ++n) g2[bj][n] = *(const f32x4*)(modr + 5120 + col0 + bj * 128 + n * 16);
#pragma unroll
        for (int ai = 0; ai < 2; ++ai)
#pragma unroll
            for (int m = 0; m < 4; ++m) { const size_t row = (size_t)pm * 256 + ai * 128 + wr * 64 + m * 16 + fr;
#pragma unroll
                for (int bj = 0; bj < 2; ++bj)
#pragma unroll
                    for (int n = 0; n < 2; ++n) { const size_t off = row * DM + col0 + bj * 128 + n * 16;
                        const f32x4 xv = *(const f32x4*)(x1 + off); *(f32x4*)(x1 + off) = xv + g2[bj][n] * acc[ai][bj][m][n]; }
                if (m & 1) asm volatile("" ::: "memory"); }
    }
};

namespace attn_body {
using bf16 = __hip_bfloat16;
using s16x4 = __attribute__((ext_vector_type(4))) short;
using f32x16 = __attribute__((ext_vector_type(16))) float;
constexpr int D = 64, NW = 8, QBLK = 32, QB = QBLK * NW, KVBLK = 64;
__device__ __forceinline__ int crow(int r, int hi) { return (r & 3) + 8 * (r >> 2) + 4 * hi; }
#define SBAR() __builtin_amdgcn_sched_barrier(0)
constexpr int NSLOT = 3, SLOTB = 8192;
constexpr int LDS_K = 0, LDS_V = NSLOT * SLOTB, LDS_WS = 2 * NSLOT * SLOTB, LDS_OST = LDS_WS + NW * 64 * 4, LDS_BYTES = LDS_OST + NW * 4096;
constexpr int LDS_MASK = 120320;
constexpr int LDS_TAB = 86016;
__device__ __forceinline__ void glds16(const void* sbase, unsigned voff, unsigned lds_dst) { unsigned keep;
    asm volatile("s_nop 4\n\ts_mov_b32 %0, m0\n\ts_mov_b32 m0, %3\n\ts_nop 0\n\tglobal_load_lds_dwordx4 %1, %2\n\ts_mov_b32 m0, %0" : "=&s"(keep) : "v"(voff), "s"(sbase), "s"(lds_dst) : "memory"); }
__device__ __forceinline__ float max3f(float a, float b, float c) { float r; asm("v_max3_f32 %0, %1, %2, %3" : "=v"(r) : "v"(a), "v"(b), "v"(c)); return r; }
__device__ __forceinline__ float max2f(float a, float b) { float r; asm("v_max_f32_e32 %0, %1, %2" : "=v"(r) : "v"(a), "v"(b)); return r; }
__device__ __forceinline__ float fadd_s(float a, float b) { float r; asm("v_add_f32_e32 %0, %1, %2" : "=v"(r) : "v"(a), "v"(b)); return r; }
__device__ __forceinline__ float fsub_s(float a, float b) { float r; asm("v_sub_f32_e32 %0, %1, %2" : "=v"(r) : "v"(a), "v"(b)); return r; }
typedef float f32x2_t __attribute__((ext_vector_type(2))); typedef __bf16 bf16x2_t __attribute__((ext_vector_type(2)));
__device__ __forceinline__ unsigned cvtpk_s(float lo, float hi) { f32x2_t v = {lo, hi}; bf16x2_t b = __builtin_convertvector(v, bf16x2_t); return __builtin_bit_cast(unsigned, b); }
#define WAIT_BAR(N) asm volatile("s_waitcnt vmcnt(" #N ") lgkmcnt(0)\n\ts_barrier" ::: "memory")

__device__ __forceinline__ void qkt(f32x16& p0, f32x16& p1, const char* Kslot, const bf16x8* qr, const f32x16& negm, int r32, int hi) {
    const char* kb = Kslot + hi * 1024 + r32 * 16;
#pragma unroll
    for (int d0 = 0; d0 < 4; ++d0) {
        const bf16x8 b0 = *reinterpret_cast<const bf16x8*>(kb + d0 * 2048);
        const bf16x8 b1 = *reinterpret_cast<const bf16x8*>(kb + d0 * 2048 + 512);
        if (d0 == 0) { p0 = __builtin_amdgcn_mfma_f32_32x32x16_bf16(b0, qr[0], negm, 0, 0, 0); p1 = __builtin_amdgcn_mfma_f32_32x32x16_bf16(b1, qr[0], negm, 0, 0, 0); }
        else { p0 = __builtin_amdgcn_mfma_f32_32x32x16_bf16(b0, qr[d0], p0, 0, 0, 0); p1 = __builtin_amdgcn_mfma_f32_32x32x16_bf16(b1, qr[d0], p1, 0, 0, 0); } }
}
typedef __attribute__((address_space(3))) const char* lds_cptr;
typedef short v4i16_t __attribute__((ext_vector_type(4)));
__device__ __forceinline__ void kload8(bf16x8* kf, lds_cptr kp) {
    kf[0] = *(const LAS bf16x8*)(kp);        kf[1] = *(const LAS bf16x8*)(kp + 512);
    kf[2] = *(const LAS bf16x8*)(kp + 2048); kf[3] = *(const LAS bf16x8*)(kp + 2560);
    kf[4] = *(const LAS bf16x8*)(kp + 4096); kf[5] = *(const LAS bf16x8*)(kp + 4608);
    kf[6] = *(const LAS bf16x8*)(kp + 6144); kf[7] = *(const LAS bf16x8*)(kp + 6656);
}
__device__ __forceinline__ void kload2(bf16x8* kf, lds_cptr kp, int j) { kf[2 * j] = *(const LAS bf16x8*)(kp + j * 2048); kf[2 * j + 1] = *(const LAS bf16x8*)(kp + j * 2048 + 512); }
__device__ __forceinline__ s16x4 vtr(lds_cptr p) { return __builtin_bit_cast(s16x4, __builtin_amdgcn_ds_read_tr16_b64_v4i16((LAS v4i16_t*)p)); }
__device__ __forceinline__ float rowmax(const f32x16& p0, const f32x16& p1) {
    float a = max3f(p0[0], p0[1], p1[0]), b = max3f(p0[2], p0[3], p1[1]); a = max3f(a, p1[2], p1[3]);
#pragma unroll
    for (int r = 4; r < 16; r += 4) { a = max3f(a, p0[r], p0[r + 1]); b = max3f(b, p0[r + 2], p0[r + 3]); a = max3f(a, p1[r], p1[r + 1]); b = max3f(b, p1[r + 2], p1[r + 3]); }
    const float m = max2f(a, b);
    auto rr = __builtin_amdgcn_permlane32_swap(__float_as_uint(m), __float_as_uint(m), false, false);
    return max2f(__uint_as_float(rr[0]), __uint_as_float(rr[1]));
}
__device__ __forceinline__ void pv(f32x16* o, int vb, bf16x8 pa0, bf16x8 pa1, bf16x8 pa2, bf16x8 pa3) {
#pragma unroll
    for (int d0 = 0; d0 < 2; ++d0) { s16x4 lo[4], hi[4];
#pragma unroll
        for (int ks = 0; ks < 4; ++ks) {
            asm volatile("ds_read_b64_tr_b16 %0,%1 offset:%c2" : "=&v"(lo[ks]) : "v"(vb), "i"(d0 * 4096 + ks * 1024) : "memory");
            asm volatile("ds_read_b64_tr_b16 %0,%1 offset:%c2" : "=&v"(hi[ks]) : "v"(vb), "i"(d0 * 4096 + ks * 1024 + 512) : "memory"); }
        asm volatile("s_waitcnt lgkmcnt(0)" ::: "memory"); SBAR();
#define PK(k) (bf16x8){lo[k][0], lo[k][1], lo[k][2], lo[k][3], hi[k][0], hi[k][1], hi[k][2], hi[k][3]}
        o[d0] = __builtin_amdgcn_mfma_f32_32x32x16_bf16(pa0, PK(0), o[d0], 0, 0, 0);
        o[d0] = __builtin_amdgcn_mfma_f32_32x32x16_bf16(pa1, PK(1), o[d0], 0, 0, 0);
        o[d0] = __builtin_amdgcn_mfma_f32_32x32x16_bf16(pa2, PK(2), o[d0], 0, 0, 0);
        o[d0] = __builtin_amdgcn_mfma_f32_32x32x16_bf16(pa3, PK(3), o[d0], 0, 0, 0);
#undef PK
    }
}

struct AttnDesc { const bf16* Qw0; bf16* Ow0; const bf16* Kh; const bf16* Vh; int qp, kp, NT, lo, qrow0; };

constexpr int TABR = 132, TABC = 2128;
constexpr int MSKR = 68;
template <int HK> __device__ __forceinline__ void nb_hook(f32x16& C0, f32x16& C1, int t, int lo, int qrow, int qc, int hi, float mhat, const LAS float* tab, const LAS float* maskT) {
    if (HK == 0) {
#pragma unroll
        for (int r = 0; r < 16; ++r) { C0[r] -= mhat; C1[r] -= mhat; }
    } else {
        const int kr = lo + t - 8;
        int rs = qrow - 4; rs = rs < 0 ? 0 : (rs > 56 ? 56 : rs);
        const bool rowok = (kr >= rs && kr < rs + 8);
        const int dr = rowok ? (kr - qrow + 7) : 15;
        const LAS f32x4* bp = (const LAS f32x4*)(tab + (qc & 3) * (TABC + 1) + dr * TABR + (64 + 4 * hi - qc));
        const LAS f32x4* mp = (const LAS f32x4*)(maskT + (rowok ? qc : 64) * MSKR + 4 * hi);
        {   f32x4 b[4];
#pragma unroll
            for (int g = 0; g < 4; ++g) b[g] = bp[2 * g] + mp[2 * g];
#pragma unroll
            for (int g = 0; g < 4; ++g)
#pragma unroll
                for (int e = 0; e < 4; ++e) { const int r = 4 * g + e; C0[r] += b[g][e] - mhat; }
        }
        __builtin_amdgcn_sched_barrier(0);
        {   f32x4 b[4];
#pragma unroll
            for (int g = 0; g < 4; ++g) b[g] = bp[2 * g + 8] + mp[2 * g + 8];
#pragma unroll
            for (int g = 0; g < 4; ++g)
#pragma unroll
                for (int e = 0; e < 4; ++e) { const int r = 4 * g + e; C1[r] += b[g][e] - mhat; }
        }
    }
}

#define ATTN_STORE16(p, v) (*(u32x4*)(p) = (v))
template <int MODE, int THRL> __device__ __forceinline__ void attn_unit(const AttnDesc& ds, char* shm) {
    int tid = threadIdx.x; asm volatile("" : "+v"(tid));
    const int lane = tid & 63, r32 = lane & 31, hi = lane >> 5; const int wid = __builtin_amdgcn_readfirstlane(tid >> 6);
    const int qp = ds.qp, kp = ds.kp, NT = ds.NT, lo = ds.lo;
    const bf16* Qw = ds.Qw0 + (long)(wid * QBLK) * qp;
    const bf16* Kh = ds.Kh; const bf16* Vh = ds.Vh;
    const unsigned lds0 = (unsigned)(uintptr_t)shm;
    float* wsf = (float*)(shm + LDS_WS) + wid * 64;
#define KOFF(l_) ((unsigned)(((l_) * kp + wid * 8) * 2))
#define VOFF(l_) ((unsigned)(((16 * (wid & 3) + ((l_) >> 2)) * kp + (wid >> 2) * 32 + ((l_) & 3) * 8) * 2))
    const unsigned koff = KOFF(lane), voff = VOFF(lane);
    const unsigned kdst = lds0 + LDS_K + wid * 1024, vdst = lds0 + LDS_V + wid * 1024;
    const long tstride = (long)KVBLK * kp;
#define TROW(t) ((long)((t) + ((MODE == 1 && (t) >= 8) ? lo : 0)) * tstride)
#define LANE_FRESH() ({ int l_ = (int)__builtin_amdgcn_mbcnt_hi(~0u, __builtin_amdgcn_mbcnt_lo(~0u, 0u)); asm volatile("" : "+v"(l_)); l_; })
#define DMA_K(t, slot) glds16(Kh + TROW(t), (MODE == 1) ? KOFF(LANE_FRESH()) : koff, (unsigned)__builtin_amdgcn_readfirstlane(kdst + (slot)))
#define DMA_V(t, slot) glds16(Vh + TROW(t), (MODE == 1) ? VOFF(LANE_FRESH()) : voff, (unsigned)__builtin_amdgcn_readfirstlane(vdst + (slot)))
    const int vb0 = (int)(lds0 + LDS_V) + ((lane >> 4) & 1) * 32 + (lane & 3) * 8 + (4 * hi + ((lane & 15) >> 2)) * 64;
    const char* Kbase = shm + LDS_K; bf16x8 kf[8];
    const lds_cptr shm3 = (lds_cptr)shm; const lds_cptr kp0 = shm3 + LDS_K + hi * 1024 + r32 * 16; const lds_cptr vp0 = shm3 + LDS_V + ((lane >> 4) & 1) * 32 + (lane & 3) * 8 + (4 * hi + ((lane & 15) >> 2)) * 64;
    const LAS float* tab = (const LAS float*)(shm3 + LDS_TAB); const LAS float* maskT = (const LAS float*)(shm3 + LDS_MASK);
    const int qrow = ds.qrow0 + (wid >> 1), qc = (wid & 1) * 32 + r32;
    DMA_K(0, 0); DMA_V(0, 0); DMA_K(1, SLOTB);
    bf16x8 qr[4];
#pragma unroll
    for (int d0 = 0; d0 < 4; ++d0) qr[d0] = *reinterpret_cast<const bf16x8*>(&Qw[(long)r32 * qp + d0 * 16 + hi * 8]);
    float mhat = 0.f, l_reg = 0.f; f32x16 o[2]; o[0] = f32x16{}; o[1] = f32x16{}; f32x16 negm = f32x16{}; if (MODE == 0) asm volatile("" : "+v"(negm));
#define CMASK(P0, P1, t, HK) do { if (MODE == 1) nb_hook<HK>(P0, P1, (t), lo, qrow, qc, hi, mhat, tab, maskT); } while (0)
    bool resc = false;
#define START(P0, P1) do { const float rm = rowmax(P0, P1); resc = false; \
    { const float dl = rm; mhat = fadd_s(mhat, dl); \
      _Pragma("unroll") for (int r = 0; r < 16; ++r) { P0[r] = fsub_s(P0[r], dl); P1[r] = fsub_s(P1[r], dl); } \
      if (MODE == 0) { _Pragma("unroll") for (int r = 0; r < 16; ++r) negm[r] = -mhat; asm volatile("" : "+v"(negm)); } } \
    _Pragma("unroll") for (int r = 0; r < 16; ++r) P0[r] = __builtin_amdgcn_exp2f(P0[r]); } while (0)
#define RESC() do { if (resc) { asm volatile("s_waitcnt lgkmcnt(0)" ::: "memory"); \
      _Pragma("unroll") for (int d_ = 0; d_ < 2; ++d_) _Pragma("unroll") for (int r = 0; r < 16; ++r) o[d_][r] *= wsf[crow(r, hi)]; } } while (0)
    f32x16 pA0, pA1, pB0, pB1;
    int sl_prev = 0, sl_cur = 0, sl_next = SLOTB;
#define ROT() do { sl_prev = sl_cur; sl_cur = sl_next; sl_next = (sl_next == (NSLOT - 1) * SLOTB) ? 0 : sl_next + SLOTB; } while (0)
    DMA_K(2, 2 * SLOTB);
    WAIT_BAR(3);
    qkt(pA0, pA1, Kbase, qr, negm, r32, hi); asm volatile("s_nop 15\n\ts_nop 7" : "+v"(pA0), "+v"(pA1));
    START(pA0, pA1);
    _Pragma("unroll") for (int r = 0; r < 16; ++r) pA1[r] = __builtin_amdgcn_exp2f(pA1[r]);
    WAIT_BAR(0);
    DMA_K(3, 0); DMA_V(1, SLOTB);
    ROT();
    kload8(kf, kp0 + sl_cur);
    WAIT_BAR(2);
    s16x4 vlo[8], vhi[8]; u32x4 pw0, pw1, pw2, pw3;
#define PKW(P, B) cvtpk_s(P[B], P[B + 1])
#define PAF(k) __builtin_bit_cast(bf16x8, pw##k)
#define VFR(i) (bf16x8){vlo[i][0], vlo[i][1], vlo[i][2], vlo[i][3], vhi[i][0], vhi[i][1], vhi[i][2], vhi[i][3]}
#define PIN(x) asm volatile("" : "+v"(x))
#define MX3(a, b, c) __builtin_fmaxf(__builtin_fmaxf((a), (b)), (c))
#define GAPA(MF, A0, A1, A2, A3, W0, W1, PW) do { MF; sacc += A0; sacc += A1; sacc += A2; sacc += A3; PIN(sacc); W0; W1; PIN(PW); SBAR(); } while (0)
#define EX(v) __builtin_amdgcn_exp2f(v)
#define GAPB(MF, X, B) do { MF; X[B] = EX(X[B]); X[B + 1] = EX(X[B + 1]); X[B + 2] = EX(X[B + 2]); X[B + 3] = EX(X[B + 3]); PIN(X); SBAR(); } while (0)
#define VRD(i) do { vlo[i] = vtr(vp_ + (((i) >> 2) * 4096 + ((i) & 3) * 1024)); vhi[i] = vtr(vp_ + (((i) >> 2) * 4096 + ((i) & 3) * 1024 + 512)); } while (0)
#define KRD(G, j) do { if (G) { kload2(kf, kp0 + sl_next, j); SBAR(); } } while (0)
#define STEP(C0, C1, P0, P1, t, GK, GV, GL, HK) do { SBAR(); \
    const lds_cptr vp_ = vp0 + sl_prev; \
    VRD(0); SBAR(); float sacc = (P0[0] + P0[1]); \
    GAPA(C0 = __builtin_amdgcn_mfma_f32_32x32x16_bf16(kf[0], qr[0], negm, 0, 0, 0), P0[2], P0[3], P0[4], P0[5],     pw0[0] = PKW(P0, 0), pw0[1] = PKW(P0, 2), pw0); \
    VRD(4); SBAR(); GAPA(C1 = __builtin_amdgcn_mfma_f32_32x32x16_bf16(kf[1], qr[0], negm, 0, 0, 0), P0[6], P0[7], P0[8], P0[9],     pw0[2] = PKW(P0, 4), pw0[3] = PKW(P0, 6), pw0); \
    VRD(1); SBAR(); GAPA(C0 = __builtin_amdgcn_mfma_f32_32x32x16_bf16(kf[2], qr[1], C0, 0, 0, 0),   P0[10], P0[11], P0[12], P0[13], pw1[0] = PKW(P0, 8), pw1[1] = PKW(P0, 10), pw1); \
    VRD(5); SBAR(); GAPA(C1 = __builtin_amdgcn_mfma_f32_32x32x16_bf16(kf[3], qr[1], C1, 0, 0, 0),   P0[14], P0[15], P1[0], P1[1],   pw1[2] = PKW(P0, 12), pw1[3] = PKW(P0, 14), pw1); \
    VRD(2); SBAR(); GAPA(C0 = __builtin_amdgcn_mfma_f32_32x32x16_bf16(kf[4], qr[2], C0, 0, 0, 0),   P1[2], P1[3], P1[4], P1[5],     pw2[0] = PKW(P1, 0), pw2[1] = PKW(P1, 2), pw2); \
    VRD(6); SBAR(); GAPA(C1 = __builtin_amdgcn_mfma_f32_32x32x16_bf16(kf[5], qr[2], C1, 0, 0, 0),   P1[6], P1[7], P1[8], P1[9],     pw2[2] = PKW(P1, 4), pw2[3] = PKW(P1, 6), pw2); \
    VRD(3); SBAR(); GAPA(C0 = __builtin_amdgcn_mfma_f32_32x32x16_bf16(kf[6], qr[3], C0, 0, 0, 0),   P1[10], P1[11], P1[12], P1[13], pw3[0] = PKW(P1, 8), pw3[1] = PKW(P1, 10), pw3); \
    VRD(7); SBAR(); GAPA(C1 = __builtin_amdgcn_mfma_f32_32x32x16_bf16(kf[7], qr[3], C1, 0, 0, 0),   P1[14], P1[15], 0.f, 0.f,       pw3[2] = PKW(P1, 12), pw3[3] = PKW(P1, 14), pw3); \
    l_reg += sacc; \
    if (GK) { DMA_K((t) + 3, sl_cur); } if (GV) { DMA_V((t) + 1, sl_next); } \
    CMASK(C0, C1, t, HK); \
    { float a = MX3(C0[0], C0[1], C1[0]), b = MX3(C0[2], C0[3], C1[1]); a = MX3(a, C1[2], C1[3]); \
      _Pragma("unroll") for (int r = 4; r < 16; r += 4) { a = MX3(a, C0[r], C0[r + 1]); b = MX3(b, C0[r + 2], C0[r + 3]); a = MX3(a, C1[r], C1[r + 1]); b = MX3(b, C1[r + 2], C1[r + 3]); } \
      float rm = __builtin_fmaxf(a, b); { auto rr = __builtin_amdgcn_permlane32_swap(__float_as_uint(rm), __float_as_uint(rm), false, false); rm = __builtin_fmaxf(__uint_as_float(rr[0]), __uint_as_float(rr[1])); } \
      resc = false; \
      if (__builtin_expect(__any(rm > (float)THRL), 0)) { const float dl = __builtin_fmaxf(rm, 0.f); mhat += dl; \
        _Pragma("unroll") for (int r = 0; r < 16; ++r) { C0[r] -= dl; C1[r] -= dl; } \
        if (MODE == 0) { _Pragma("unroll") for (int r = 0; r < 16; ++r) negm[r] = -mhat; asm volatile("" : "+v"(negm)); } \
        const float f = __builtin_amdgcn_exp2f(-dl); l_reg *= f; if (hi == 0) wsf[r32] = f; resc = true; } } \
    SBAR(); \
    GAPB(o[0] = __builtin_amdgcn_mfma_f32_32x32x16_bf16(PAF(0), VFR(0), o[0], 0, 0, 0), C0, 0); \
    GAPB(o[1] = __builtin_amdgcn_mfma_f32_32x32x16_bf16(PAF(0), VFR(4), o[1], 0, 0, 0), C0, 4); \
    KRD(GL, 0); GAPB(o[0] = __builtin_amdgcn_mfma_f32_32x32x16_bf16(PAF(1), VFR(1), o[0], 0, 0, 0), C0, 8); \
    KRD(GL, 1); GAPB(o[1] = __builtin_amdgcn_mfma_f32_32x32x16_bf16(PAF(1), VFR(5), o[1], 0, 0, 0), C0, 12); \
    KRD(GL, 2); GAPB(o[0] = __builtin_amdgcn_mfma_f32_32x32x16_bf16(PAF(2), VFR(2), o[0], 0, 0, 0), C1, 0); \
    KRD(GL, 3); GAPB(o[1] = __builtin_amdgcn_mfma_f32_32x32x16_bf16(PAF(2), VFR(6), o[1], 0, 0, 0), C1, 4); \
    GAPB(o[0] = __builtin_amdgcn_mfma_f32_32x32x16_bf16(PAF(3), VFR(3), o[0], 0, 0, 0), C1, 8); \
    GAPB(o[1] = __builtin_amdgcn_mfma_f32_32x32x16_bf16(PAF(3), VFR(7), o[1], 0, 0, 0), C1, 12); \
    } while (0)
    int t = 1;
    if (MODE == 1) {
        for (; t < 7; t += 2) {
            STEP(pB0, pB1, pA0, pA1, t, true, true, true, 0);     WAIT_BAR(2); RESC(); ROT();
            STEP(pA0, pA1, pB0, pB1, t + 1, true, true, true, 0); WAIT_BAR(2); RESC(); ROT();
        }
        STEP(pB0, pB1, pA0, pA1, t, true, true, true, 0);     WAIT_BAR(2); RESC(); ROT();
        STEP(pA0, pA1, pB0, pB1, t + 1, true, true, true, 1); WAIT_BAR(2); RESC(); ROT();
        t += 2;
    }
    for (; t + 5 < NT; t += 2) {
        STEP(pB0, pB1, pA0, pA1, t, true, true, true, 1);     WAIT_BAR(2); RESC(); ROT();
        STEP(pA0, pA1, pB0, pB1, t + 1, true, true, true, 1); WAIT_BAR(2); RESC(); ROT();
    }
#define ENDW(tt) do { if ((tt) + 3 < NT) { WAIT_BAR(2); } else if ((tt) + 2 < NT) { WAIT_BAR(1); } else { WAIT_BAR(0); } } while (0)
    for (; t + 1 < NT; t += 2) {
        STEP(pB0, pB1, pA0, pA1, t, (t + 3 < NT), (t + 1 < NT), (t + 1 < NT), 1);     ENDW(t);     RESC(); ROT();
        STEP(pA0, pA1, pB0, pB1, t + 1, (t + 4 < NT), (t + 2 < NT), (t + 2 < NT), 1); ENDW(t + 1); RESC(); ROT();
    }
    STEP(pB0, pB1, pA0, pA1, NT - 1, false, false, false, 1); RESC();
    { float sacc = pB0[0] + pB0[1]; _Pragma("unroll") for (int r = 2; r < 16; ++r) sacc += pB0[r]; _Pragma("unroll") for (int r = 0; r < 16; ++r) sacc += pB1[r]; l_reg += sacc;
      pw0 = (u32x4){PKW(pB0, 0), PKW(pB0, 2), PKW(pB0, 4), PKW(pB0, 6)}; pw1 = (u32x4){PKW(pB0, 8), PKW(pB0, 10), PKW(pB0, 12), PKW(pB0, 14)}; pw2 = (u32x4){PKW(pB1, 0), PKW(pB1, 2), PKW(pB1, 4), PKW(pB1, 6)}; pw3 = (u32x4){PKW(pB1, 8), PKW(pB1, 10), PKW(pB1, 12), PKW(pB1, 14)};
      SBAR(); pv(o, vb0 + sl_cur, PAF(0), PAF(1), PAF(2), PAF(3)); }
#undef PKW
#undef PAF
#undef VFR
#undef PIN
#undef MX3
#undef GAPA
#undef GAPB
#undef EX
#undef VRD
#undef KRD
#undef STEP
#undef ENDW
    { auto rr = __builtin_amdgcn_permlane32_swap(__float_as_uint(l_reg), __float_as_uint(l_reg), false, false); l_reg = __uint_as_float(rr[0]) + __uint_as_float(rr[1]); }
    if (hi == 0) wsf[32 + r32] = l_reg; asm volatile("s_waitcnt lgkmcnt(0)" ::: "memory");
    float rli[16];
#pragma unroll
    for (int r = 0; r < 16; ++r) rli[r] = __builtin_amdgcn_rcpf(wsf[32 + crow(r, hi)]);
    bf16* Ow = ds.Ow0 + (long)(wid * QBLK) * qp;
    { bf16* stg = (bf16*)(shm + LDS_OST) + wid * 2048;
#pragma unroll
      for (int r = 0; r < 16; ++r) { const int orow = crow(r, hi);
#pragma unroll
          for (int d0 = 0; d0 < 2; ++d0) stg[orow * 64 + d0 * 32 + r32] = __float2bfloat16(o[d0][r] * rli[r]); }
      asm volatile("s_waitcnt lgkmcnt(0)" ::: "memory");
#pragma unroll
      for (int i = 0; i < 4; ++i) { const int row = i * 8 + (lane >> 3), ch = lane & 7; const u32x4 v = *(const u32x4*)(stg + row * 64 + ch * 8); ATTN_STORE16(Ow + (long)row * qp + ch * 8, v); } }
    asm volatile("s_waitcnt lgkmcnt(0)\n\ts_barrier" ::: "memory");
#undef DMA_K
#undef DMA_V
#undef LANE_FRESH
#undef KOFF
#undef VOFF
#undef TROW
#undef CMASK
#undef START
#undef RESC
#undef ROT
}
#undef SBAR
#undef WAIT_BAR
}

constexpr int RING_BYTES = 131072;
constexpr int LDS_BYTES = 147456;
constexpr int NWAVES = 8;
constexpr int NPHASE = 9;

struct Frame {
    LAS unsigned char* lds; int tid, lane, wave, vcu, G;
};

__device__ __forceinline__ unsigned f2bf(float f) { unsigned u = __builtin_bit_cast(unsigned, f); return (u + 0x7fffu + ((u >> 16) & 1u)) >> 16; }
__device__ __forceinline__ unsigned pk2(float lo, float hi) { return f2bf(lo) | (f2bf(hi) << 16); }

__device__ __forceinline__ void gemv9_item(const LAS float* Sl, LAS float* red, const float* W, int ldw, int col0, float* out, int ldo, const float* bias, int tid) {
    const int col = tid & 63, kq = tid >> 6;
    float a0 = 0.f, a1 = 0.f, a2 = 0.f, a3 = 0.f, a4 = 0.f, a5 = 0.f, a6 = 0.f, a7 = 0.f, a8 = 0.f;
    const float* wp = W + (size_t)(kq * 128) * ldw + col0 + col;
#pragma unroll 8
    for (int kk = 0; kk < 128; ++kk) {
        const float w = wp[(size_t)kk * ldw];
        const LAS f32x4* sp = (const LAS f32x4*)(Sl + (kq * 128 + kk) * 12);
        const f32x4 s0 = sp[0], s1 = sp[1], s2 = sp[2];
        a0 += s0[0] * w; a1 += s0[1] * w; a2 += s0[2] * w; a3 += s0[3] * w; a4 += s1[0] * w; a5 += s1[1] * w; a6 += s1[2] * w; a7 += s1[3] * w; a8 += s2[0] * w;
    }
    LAS float* rp = red + (kq * 9) * 64 + col;
    rp[0] = a0; rp[64] = a1; rp[128] = a2; rp[192] = a3; rp[256] = a4; rp[320] = a5; rp[384] = a6; rp[448] = a7; rp[512] = a8;
    __syncthreads();
    for (int i = tid; i < 576; i += 512) { const int r = i >> 6, c = i & 63; float s = 0.f;
#pragma unroll
        for (int q = 0; q < 8; ++q) s += red[(q * 9 + r) * 64 + c];
        out[(size_t)r * ldo + col0 + c] = s + (bias ? bias[col0 + c] : 0.f); }
    __syncthreads();
}

__device__ __forceinline__ void transpose_item(const float* W, int K, int N, bf16_t* WT, LAS float* scr, int item, int lane, bool permw) {
    const int nblk = N / 32, kb = item / nblk, nb = item % nblk, k0 = 64 * kb, n0 = 32 * nb;
    int d0 = n0;
    if (permw) { const int T = n0 >> 8, w = (n0 >> 6) & 3, bj = (n0 >> 5) & 1; d0 = 256 * T + 128 * bj + 32 * w; }
#pragma unroll 8
    for (int i = 0; i < 32; ++i) { const int kk = 2 * i + (lane >> 5); scr[kk * 33 + (lane & 31)] = W[(size_t)(k0 + kk) * N + n0 + (lane & 31)]; }
    asm volatile("s_waitcnt lgkmcnt(0)" ::: "memory");
    const int c = lane & 7;
#pragma unroll
    for (int j = 0; j < 4; ++j) { const int n = (lane >> 3) + 8 * j; const LAS float* s = scr + (8 * c) * 33 + n;
        u32x4 o; o.x = pk2(s[0 * 33], s[1 * 33]); o.y = pk2(s[2 * 33], s[3 * 33]); o.z = pk2(s[4 * 33], s[5 * 33]); o.w = pk2(s[6 * 33], s[7 * 33]);
        *(u32x4*)(WT + (size_t)(d0 + n) * K + k0 + 8 * c) = o; }
    asm volatile("s_waitcnt lgkmcnt(0)" ::: "memory");
}

struct Args { const float* in[22]; float* out; unsigned char* ws; int ph_lo, ph_hi; };

__global__ void __launch_bounds__(NWAVES * 64, 2) fwd_kernel(Args args) {
    extern __shared__ __attribute__((aligned(16))) unsigned char lds[];
    Frame F;
    F.lds = (LAS unsigned char*)lds;
    F.tid = 0; F.lane = 0; F.wave = __builtin_amdgcn_readfirstlane(threadIdx.x >> 6);
    F.G = gridDim.x; { const int bx = blockIdx.x; F.vcu = (F.G % 8 == 0) ? (bx % 8) * (F.G / 8) + bx / 8 : bx; }
#define KARG(T, idx) ({ unsigned o_ = (unsigned)(idx) * 8u; asm volatile("" : "+s"(o_)); (T)(*(const unsigned long long __attribute__((address_space(4)))*)((const char __attribute__((address_space(4)))*)__builtin_amdgcn_kernarg_segment_ptr() + o_)); })
#define IN_X_PROMPT 0
#define IN_X_SAMPLE 1
#define IN_CACHE_AK 2
#define IN_CACHE_AV 3
#define IN_CACHE_BK 4
#define IN_CACHE_BV 5
#define IN_C 6
#define IN_C_CTX 7
#define IN_W_MOD 8
#define IN_B_MOD 9
#define IN_N1G 10
#define IN_N2G 11
#define IN_W_IN 12
#define IN_QNG 13
#define IN_KNG 14
#define IN_NAT_BIAS 15
#define IN_W_BRA 16
#define IN_W_BRB 17
#define IN_W_OUT 18
#define IN_W_1 19
#define IN_W_2 20
#define IN_FNG 21
#define ARG_OUT 22
#define ARG_WS 23
#define WSP(T, off) ((T)(ws + (off)))
#define FRESH_TID() do { int t_ = threadIdx.x; asm volatile("" : "+v"(t_)); F.tid = t_; F.lane = t_ & 63; } while (0)
#if MK_PER_PHASE
    const int lo = args.ph_lo, hi = args.ph_hi;
#else
    constexpr int lo = 0, hi = NPHASE;
#endif
#define IN(k) (lo <= (k) && (k) < hi)
#define SEAM(k) do { if (IN(k) && IN((k) + 1)) { asm volatile("s_waitcnt vmcnt(0) lgkmcnt(0)" ::: "memory"); __syncthreads(); cg::this_grid().sync(); } } while (0)

    if (IN(0)) {
        FRESH_TID();
        unsigned char* ws = KARG(unsigned char*, ARG_WS);
        const float* cvec = KARG(const float*, IN_C); const float* c_ctx = KARG(const float*, IN_C_CTX); const float* w_mod = KARG(const float*, IN_W_MOD); const float* b_mod = KARG(const float*, IN_B_MOD);
        const float* cache_ak = KARG(const float*, IN_CACHE_AK); const float* cache_av = KARG(const float*, IN_CACHE_AV); const float* cache_bk = KARG(const float*, IN_CACHE_BK); const float* cache_bv = KARG(const float*, IN_CACHE_BV);
        float* MOD = WSP(float*, WS_MOD); float* ROPEC = WSP(float*, WS_ROPE); float* ROPES = ROPEC + 1024;
        bf16_t* KA = WSP(bf16_t*, WS_KA); bf16_t* VA = WSP(bf16_t*, WS_VA); bf16_t* KB = WSP(bf16_t*, WS_KB); bf16_t* VB = WSP(bf16_t*, WS_VB);
        LAS float* Sl = (LAS float*)F.lds; LAS float* red = (LAS float*)(F.lds + 49152);
        if ((int)blockIdx.x < 96) {
            for (int i = F.tid; i < 9 * 1024; i += 512) { const int r = i >> 10, k = i & 1023; const float v = (r < 8) ? cvec[r * 1024 + k] : c_ctx[k]; Sl[k * 12 + r] = v / (1.0f + expf(-v)); }
            __syncthreads();
            for (int it = blockIdx.x; it < 96; it += F.G) gemv9_item(Sl, red, w_mod, NMOD, it * 64, MOD, NMOD, b_mod, F.tid);
        }
        if ((int)blockIdx.x == F.G - 1) {
            for (int i = F.tid; i < 1024; i += 512) { const int pos = i >> 4, pi = i & 15;
                const float b4 = (pi & 3) == 0 ? 1.0f : ((pi & 3) == 1 ? 0.5623413251903491f : ((pi & 3) == 2 ? 0.31622776601683794f : 0.1778279410038923f));
                const float d4 = (pi >> 2) == 0 ? 1.0f : ((pi >> 2) == 1 ? 0.1f : ((pi >> 2) == 2 ? 0.01f : 0.001f));
                const float ang = (float)pos * (b4 * d4);
                const float kq = rintf(ang * 0.15915494309189535f);
                float r = fmaf(-kq, 6.2831854820251465f, ang); r = fmaf(-kq, -1.7484555e-7f, r);
                ROPEC[i] = cosf(r); ROPES[i] = sinf(r); }
        }
        { const int gt = F.vcu * 512 + F.tid, NT_ = F.G * 512;
          for (int e = gt; e < 2 * 131072; e += NT_) {
              const int which = e >= 131072; const int q = which ? e - 131072 : e; const int b = q >> 14, p = (q >> 5) & 511, c4 = q & 31;
              const f32x4 v = *(const f32x4*)((which ? cache_av : cache_ak) + (size_t)q * 4);
              u32x2 w; w.x = pk2(v[0], v[1]); w.y = pk2(v[2], v[3]);
              *(u32x2*)((which ? VA : KA) + ((size_t)(b * KVL + p)) * 128 + c4 * 4) = w; }
          for (int e = gt; e < 2 * 524288; e += NT_) {
              const int which = e >= 524288; const int q = which ? e - 524288 : e; const int b = q >> 16, p = (q >> 7) & 511, c4 = q & 127;
              const f32x4 v = *(const f32x4*)((which ? cache_bv : cache_bk) + (size_t)q * 4);
              u32x2 w; w.x = pk2(v[0], v[1]); w.y = pk2(v[2], v[3]);
              *(u32x2*)((which ? VB : KB) + ((size_t)(b * KVL + p)) * 512 + c4 * 4) = w; } }
    }
    SEAM(0);

    if (IN(1)) {
        FRESH_TID();
        unsigned char* ws = KARG(unsigned char*, ARG_WS);
        const float* x_prompt = KARG(const float*, IN_X_PROMPT); const float* x_sample = KARG(const float*, IN_X_SAMPLE); const float* n1g = KARG(const float*, IN_N1G);
        const float* w_in = KARG(const float*, IN_W_IN); const float* w_bra = KARG(const float*, IN_W_BRA); const float* w_brb = KARG(const float*, IN_W_BRB); const float* w_out = KARG(const float*, IN_W_OUT);
        const float* w_1 = KARG(const float*, IN_W_1); const float* w_2 = KARG(const float*, IN_W_2);
        float* MOD = WSP(float*, WS_MOD); float* BUP = WSP(float*, WS_BUP); bf16_t* Hb = WSP(bf16_t*, WS_H);
        bf16_t* WIN_t = WSP(bf16_t*, WS_WIN); bf16_t* WBRA_t = WSP(bf16_t*, WS_WBRA); bf16_t* WBRB_t = WSP(bf16_t*, WS_WBRB); bf16_t* WOUT_t = WSP(bf16_t*, WS_WOUT); bf16_t* W1_t = WSP(bf16_t*, WS_W1); bf16_t* W2_t = WSP(bf16_t*, WS_W2);
        if ((int)blockIdx.x < 64) {
            LAS float* Sl = (LAS float*)F.lds; LAS float* red = (LAS float*)(F.lds + 49152);
            for (int i = F.tid; i < 9 * 1024; i += 512) { const int r = i >> 10, k = i & 1023; Sl[k * 12 + r] = MOD[(size_t)r * NMOD + 3072 + k]; }
            __syncthreads();
            for (int it = blockIdx.x; it < 64; it += F.G) gemv9_item(Sl, red, w_1, FF, it * 64, BUP, FF, nullptr, F.tid);
        }
        LAS float* scr = (LAS float*)(F.lds + F.wave * 16384);
        const int gw = F.vcu * NWAVES + F.wave, NGW = F.G * NWAVES;
        constexpr int I_IN = (DM / 64) * (NIN / 32), I_BR = (512 / 64) * (DM / 32), I_O = (DM / 64) * (DM / 32), I_1 = (DM / 64) * (FF / 32), I_2 = (FF / 64) * (DM / 32);
        constexpr int NITEMS = I_IN + 2 * I_BR + I_O + I_1 + I_2;
        for (int it = gw; it < NITEMS; it += NGW) {
            int r = it;
            if (r < I_IN) { transpose_item(w_in, DM, NIN, WIN_t, scr, r, F.lane, true); continue; } r -= I_IN;
            if (r < I_BR) { transpose_item(w_bra, 512, DM, WBRA_t, scr, r, F.lane, false); continue; } r -= I_BR;
            if (r < I_BR) { transpose_item(w_brb, 512, DM, WBRB_t, scr, r, F.lane, false); continue; } r -= I_BR;
            if (r < I_O) { transpose_item(w_out, DM, DM, WOUT_t, scr, r, F.lane, false); continue; } r -= I_O;
            if (r < I_1) { transpose_item(w_1, DM, FF, W1_t, scr, r, F.lane, false); continue; } r -= I_1;
            transpose_item(w_2, FF, DM, W2_t, scr, r, F.lane, false);
        }
        for (int m = gw; m < M; m += NGW) {
            const float* xrow = (m < MP) ? x_prompt + (size_t)m * DM : x_sample + (size_t)(m - MP) * DM;
            const int mrow = (m < MP) ? 8 : ((m - MP) >> 12);
            const float* modr = MOD + (size_t)mrow * NMOD;
            const f32x4* xr = (const f32x4*)xrow + F.lane;
            f32x4 v[4]; float s = 0.f;
#pragma unroll
            for (int j = 0; j < 4; ++j) { v[j] = xr[64 * j]; s += (v[j][0] * v[j][0] + v[j][1] * v[j][1]) + (v[j][2] * v[j][2] + v[j][3] * v[j][3]); }
            const float inv = 1.0f / sqrtf(wave_sum(s) * (1.0f / DM) + RMS_EPS);
            unsigned long long* o8 = (unsigned long long*)(Hb + (size_t)m * DM) + F.lane;
#pragma unroll
            for (int j = 0; j < 4; ++j) { const int c = 4 * F.lane + 256 * j;
                const f32x4 g = *(const f32x4*)(n1g + c), sc = *(const f32x4*)(modr + 1024 + c), sh = *(const f32x4*)(modr + c);
                const f32x4 h = ((v[j] * inv) * g) * (sc + 1.0f) + sh;
                o8[64 * j] = (unsigned long long)pk2(h[0], h[1]) | ((unsigned long long)pk2(h[2], h[3]) << 32); }
        }
    }
    SEAM(1);

    if (IN(2)) {
        unsigned char* ws = KARG(unsigned char*, ARG_WS); float* out = KARG(float*, ARG_OUT); const float* qng = KARG(const float*, IN_QNG); const float* kng = KARG(const float*, IN_KNG);
        OpsPlain P{(const char*)(ws + WS_H), (const char*)(ws + WS_WIN), (size_t)256 * DM * 2};
        pg8::StaticOrder S; S.init(M, NIN, F.G, (int)blockIdx.x);
        EpiIn E{ws, out, qng, kng};
        pg8::gemm_phase<EpiIn, pg8::StaticOrder, OpsPlain>(F.lds, P, DM, S, E);
    }
    SEAM(2);

    if (IN(3)) {
        using namespace attn_body;
        FRESH_TID();
        unsigned char* ws = KARG(unsigned char*, ARG_WS); const float* nat_bias = KARG(const float*, IN_NAT_BIAS);
        bf16_t* QA = WSP(bf16_t*, WS_QA); bf16_t* QB = WSP(bf16_t*, WS_QB); bf16_t* KA = WSP(bf16_t*, WS_KA); bf16_t* VA = WSP(bf16_t*, WS_VA); bf16_t* KB = WSP(bf16_t*, WS_KB); bf16_t* VB = WSP(bf16_t*, WS_VB);
        char* shm = (char*)lds;
        const int x = F.vcu >> 5, j = F.vcu & 31;
        if (F.G == 256) {
            { LAS float* mw = (LAS float*)(F.lds + LDS_MASK);
              for (int e = F.tid; e < 65 * MSKR; e += 512) { const int qc_ = e / MSKR, kc_ = e - qc_ * MSKR; int cs = qc_ - 8; cs = cs < 0 ? 0 : (cs > 48 ? 48 : cs); mw[e] = (qc_ < 64 && kc_ >= cs && kc_ < cs + 16) ? 0.f : -INFINITY; } }
            for (int i = 0; i < 4; ++i) {
                const int uu = i * 32 + j, grp = 2 * x + (uu >> 6), b = grp >> 1, kvh = grp & 1, h = kvh * 4 + ((uu & 63) >> 4), qb = uu & 15;
                const size_t row0 = (size_t)MP + (size_t)b * SEQS + (size_t)qb * 256;
                AttnDesc d; d.Qw0 = (const bf16*)QA + row0 * 512 + h * 64; d.Ow0 = (bf16*)QA + row0 * 512 + h * 64;
                d.Kh = (const bf16*)KA + (size_t)b * KVL * 128 + kvh * 64; d.Vh = (const bf16*)VA + (size_t)b * KVL * 128 + kvh * 64;
                d.qp = 512; d.kp = 128; d.NT = KVL / 64; d.lo = 0; d.qrow0 = 0;
                attn_unit<0, 8>(d, shm);
            }
            for (int i = 0; i < 4; ++i) {
                const int uu = i * 32 + j, pr = 8 * x + (uu >> 4), b = pr >> 3, h = pr & 7, qb = uu & 15;
                const size_t row0 = (size_t)MP + (size_t)b * SEQS + (size_t)qb * 256;
                { LAS float* tabw = (LAS float*)(F.lds + LDS_TAB);
                  for (int e = F.tid; e < 4 * 16 * 132; e += 512) { const int sc = e / 2112, rem = e - sc * 2112, dr = rem / 132, jj = rem - dr * 132, df = jj - sc - 64;
                      tabw[sc * (TABC + 1) - sc + dr * TABR + jj] = (dr < 15 && df >= -15 && df <= 15) ? nat_bias[(h * 15 + dr) * 31 + df + 15] * LOG2E : 0.f; }
                  asm volatile("s_waitcnt vmcnt(0) lgkmcnt(0)\n\ts_barrier" ::: "memory"); }
                int lo_ = 4 * qb - 4; lo_ = lo_ < 0 ? 0 : lo_; int nloc = (qb == 0 || qb == 15) ? 8 : 12; if (qb == 15) lo_ = 56; if (lo_ > 64 - nloc) lo_ = 64 - nloc;
                AttnDesc d; d.Qw0 = (const bf16*)QB + row0 * 512 + h * 64; d.Ow0 = (bf16*)QB + row0 * 512 + h * 64;
                d.Kh = (const bf16*)KB + (size_t)b * KVL * 512 + h * 64; d.Vh = (const bf16*)VB + (size_t)b * KVL * 512 + h * 64;
                d.qp = 512; d.kp = 512; d.NT = 8 + nloc; d.lo = lo_; d.qrow0 = 4 * qb;
                attn_unit<1, 8>(d, shm);
            }
            for (int i = 0; i < 2; ++i) {
                const int uu = i * 32 + j, b = 4 * x + (uu >> 4), hh = uu & 15;
                const size_t row0 = (size_t)b * SEQP, kv0 = (size_t)NBS * KVL + (size_t)b * SEQP;
                AttnDesc d; d.NT = 4; d.lo = 0; d.qrow0 = 0; d.qp = 512;
                if (hh < 8) { d.Qw0 = (const bf16*)QA + row0 * 512 + hh * 64; d.Ow0 = (bf16*)QA + row0 * 512 + hh * 64;
                    d.Kh = (const bf16*)KA + kv0 * 128 + (hh >> 2) * 64; d.Vh = (const bf16*)VA + kv0 * 128 + (hh >> 2) * 64; d.kp = 128; }
                else { const int h = hh - 8; d.Qw0 = (const bf16*)QB + row0 * 512 + h * 64; d.Ow0 = (bf16*)QB + row0 * 512 + h * 64;
                    d.Kh = (const bf16*)KB + kv0 * 512 + h * 64; d.Vh = (const bf16*)VB + kv0 * 512 + h * 64; d.kp = 512; }
                attn_unit<0, 8>(d, shm);
            }
        }
    }
    SEAM(3);

    if (IN(4)) {
        unsigned char* ws = KARG(unsigned char*, ARG_WS);
        OpsPair P{(const char*)(ws + WS_QA), (long)(WS_QB - WS_QA), (const char*)(ws + WS_WBRA), (long)(WS_WBRB - WS_WBRA), (size_t)256 * 512 * 2};
        pg8::PairOrder S; S.init(M, DM, F.G, (int)blockIdx.x);
        EpiBr E{WSP(const bf16_t*, WS_GA), WSP(const bf16_t*, WS_GB), WSP(bf16_t*, WS_MM)};
        pg8::gemm_phase<EpiBr, pg8::PairOrder, OpsPair>(F.lds, P, 512, S, E);
    }
    SEAM(4);

    if (IN(5)) {
        unsigned char* ws = KARG(unsigned char*, ARG_WS); float* out = KARG(float*, ARG_OUT);
        const float* x_prompt = KARG(const float*, IN_X_PROMPT); const float* x_sample = KARG(const float*, IN_X_SAMPLE); const float* n2g = KARG(const float*, IN_N2G);
        OpsPlain P{(const char*)(ws + WS_MM), (const char*)(ws + WS_WOUT), (size_t)256 * DM * 2};
        pg8::StaticOrder S; S.init(M, DM, F.G, (int)blockIdx.x);
        EpiOut E{x_prompt, x_sample, WSP(const float*, WS_MOD), n2g, out + OUT_Y, WSP(bf16_t*, WS_XW), WSP(float*, WS_SSQ)};
        pg8::gemm_phase<EpiOut, pg8::StaticOrder, OpsPlain>(F.lds, P, DM, S, E);
    }
    SEAM(5);

    if (IN(6)) {
        unsigned char* ws = KARG(unsigned char*, ARG_WS);
        OpsPlain P{(const char*)(ws + WS_XW), (const char*)(ws + WS_W1), (size_t)256 * DM * 2};
        pg8::StaticOrder S; S.init(M, FF, F.G, (int)blockIdx.x);
        EpiUp E{WSP(const float*, WS_SSQ), WSP(const float*, WS_BUP), WSP(bf16_t*, WS_HID)};
        pg8::gemm_phase<EpiUp, pg8::StaticOrder, OpsPlain>(F.lds, P, DM, S, E);
    }
    SEAM(6);

    if (IN(7)) {
        unsigned char* ws = KARG(unsigned char*, ARG_WS); float* out = KARG(float*, ARG_OUT);
        OpsPlain P{(const char*)(ws + WS_HID), (const char*)(ws + WS_W2), (size_t)256 * FF * 2};
        pg8::StaticOrder S; S.init(M, DM, F.G, (int)blockIdx.x);
        EpiDown E{WSP(const float*, WS_MOD), out + OUT_Y};
        pg8::gemm_phase<EpiDown, pg8::StaticOrder, OpsPlain>(F.lds, P, FF, S, E);
    }
    SEAM(7);

    if (IN(8)) {
        FRESH_TID();
        float* out = KARG(float*, ARG_OUT); const float* fng = KARG(const float*, IN_FNG);
        const int gw = F.vcu * NWAVES + F.wave, NGW = F.G * NWAVES;
        for (int m = gw; m < M; m += NGW) {
            f32x4* xr = (f32x4*)(out + OUT_Y + (size_t)m * DM) + F.lane;
            f32x4 v[4]; float s = 0.f;
#pragma unroll
            for (int j = 0; j < 4; ++j) { v[j] = xr[64 * j]; s += (v[j][0] * v[j][0] + v[j][1] * v[j][1]) + (v[j][2] * v[j][2] + v[j][3] * v[j][3]); }
            const float inv = 1.0f / sqrtf(wave_sum(s) * (1.0f / DM) + RMS_EPS);
#pragma unroll
            for (int j = 0; j < 4; ++j) { const f32x4 g = *(const f32x4*)(fng + 4 * F.lane + 256 * j); xr[64 * j] = (v[j] * inv) * g; }
        }
    }
#undef IN
#undef SEAM
}

extern "C" void kernel_launch(void* const* d_in, const int* in_sizes, int n_in, void* d_out, int out_size, void* d_ws, size_t ws_size, hipStream_t stream) {
    static int grid = 0;
    if (grid == 0) {
        if (n_in != 22 || ws_size < WS_END) { fprintf(stderr, "kernel_launch: unexpected problem (n_in %d, ws %zu)\n", n_in, ws_size); grid = -1; return; }
        int dev = 0, cus = 0, per_cu = 0;
        if (hipGetDevice(&dev) != hipSuccess || hipDeviceGetAttribute(&cus, hipDeviceAttributeMultiprocessorCount, dev) != hipSuccess) { grid = -1; return; }
        if (hipFuncSetAttribute((const void*)fwd_kernel, hipFuncAttributeMaxDynamicSharedMemorySize, LDS_BYTES) != hipSuccess) { fprintf(stderr, "kernel_launch: hipFuncSetAttribute failed\n"); grid = -1; return; }
        if (hipOccupancyMaxActiveBlocksPerMultiprocessor(&per_cu, (const void*)fwd_kernel, NWAVES * 64, LDS_BYTES) != hipSuccess || per_cu < 1) { fprintf(stderr, "kernel_launch: occupancy query says %d\n", per_cu); (void)hipGetLastError(); per_cu = 1; }
        grid = cus;
        if (grid != 256) fprintf(stderr, "kernel_launch: %d CUs; the attention phase is dealt for 256\n", grid);
    }
    if (grid < 0) return;
    Args a{};
    for (int i = 0; i < 22; ++i) a.in[i] = (const float*)d_in[i];
    a.out = (float*)d_out; a.ws = (unsigned char*)d_ws;
#if MK_PER_PHASE
    for (int p = 0; p < NPHASE; ++p) { a.ph_lo = p; a.ph_hi = p + 1; hipLaunchKernelGGL(fwd_kernel, dim3(grid), dim3(NWAVES * 64), LDS_BYTES, stream, a); }
#else
    a.ph_lo = 0; a.ph_hi = NPHASE;
    void* kargs[] = {&a};
    hipError_t e = hipLaunchCooperativeKernel((const void*)fwd_kernel, dim3(grid), dim3(NWAVES * 64), kargs, LDS_BYTES, stream);
    if (e != hipSuccess) fprintf(stderr, "kernel_launch: cooperative launch failed: %s\n", hipGetErrorString(e));
#endif
}
```

```cpp
#include <hip/hip_runtime.h>
#include <hip/hip_cooperative_groups.h>
#include <hip/hip_bf16.h>
#include <cstdio>
#include <cstdint>
#include <cmath>
namespace cg = cooperative_groups;

#ifndef MK_PER_PHASE
#define MK_PER_PHASE 0
#endif

#ifndef DEBUG_ATTN
#define DEBUG_ATTN 0
#endif
#ifndef PROBE_LO
#define PROBE_LO (-1)
#define PROBE_HI (-1)
#endif
#define PROBE_MULT 4
#ifndef STAG_P4
#define STAG_P4 0u
#define STAG_P5 0u
#define STAG_P7 0u
#endif
#ifndef DBG_THR
#define DBG_THR 2e-4f
#endif
#define LAS __attribute__((address_space(3)))
#define GAS __attribute__((address_space(1)))
typedef unsigned short bf16_t;
typedef short bf16x8 __attribute__((ext_vector_type(8)));
typedef float f32x4 __attribute__((ext_vector_type(4)));
typedef float f32x2 __attribute__((ext_vector_type(2)));
typedef unsigned u32x4 __attribute__((ext_vector_type(4)));
typedef unsigned u32x2 __attribute__((ext_vector_type(2)));

constexpr int DM = 1024, NBP = 32, SEQP = 256, NBS = 8, SEQS = 4096, PAST = 512;
constexpr int MP = NBP * SEQP, MS = NBS * SEQS, M = MP + MS;
constexpr int NIN = 4352, FF = 4096, NMOD = 6 * DM;
constexpr int KVL = PAST + SEQS;
constexpr int KVROWS = NBS * KVL + MP;
constexpr float RMS_EPS = 1e-6f;
constexpr float LOG2E = 1.4426950408889634f;
constexpr float C2 = 0.125f * LOG2E;
constexpr size_t OUT_Y = 0, OUT_AK = (size_t)M * DM, OUT_AV = OUT_AK + (size_t)MP * 128, OUT_BK = OUT_AV + (size_t)MP * 128, OUT_BV = OUT_BK + (size_t)MP * 512;
constexpr size_t MiB = 1u << 20;
constexpr size_t WS_MOD = 0, WS_BUP = 256 * 1024, WS_ROPE = 512 * 1024, WS_BAR = 768 * 1024  , WS_SSQ = 1 * MiB;
constexpr size_t WS_WIN = 4 * MiB, WS_WBRA = 13 * MiB, WS_WBRB = 14 * MiB, WS_WOUT = 15 * MiB, WS_W1 = 17 * MiB, WS_W2 = 25 * MiB;
constexpr size_t WS_H = 34 * MiB, WS_QA = 114 * MiB, WS_QB = 154 * MiB, WS_KA = 194 * MiB, WS_VA = 205 * MiB, WS_KB = 216 * MiB, WS_VB = 260 * MiB;
constexpr size_t WS_GA = 304 * MiB, WS_GB = 384 * MiB, WS_XW = 432 * MiB, WS_HID = 34 * MiB, WS_MM = 34 * MiB, WS_END = 512 * MiB;
static_assert(WS_WIN + (size_t)NIN * DM * 2 <= WS_WBRA && WS_W2 + (size_t)DM * FF * 2 <= WS_H && WS_KA + (size_t)KVROWS * 128 * 2 <= WS_VA && WS_KB + (size_t)KVROWS * 512 * 2 <= WS_VB, "ws map");
static_assert(WS_VB + (size_t)KVROWS * 512 * 2 <= WS_GA && WS_GB + (size_t)M * DM * 2 <= WS_END && WS_HID + (size_t)M * FF * 2 <= WS_XW && WS_XW + (size_t)M * DM * 2 <= WS_END, "ws map 2");
static_assert(WS_SSQ + (size_t)M * 16 * 4 <= WS_WIN, "ws map 3");

__device__ __forceinline__ unsigned cvt_pk_bf16(float lo, float hi) { unsigned r; asm volatile("v_cvt_pk_bf16_f32 %0, %1, %2" : "=v"(r) : "v"(lo), "v"(hi)); return r; }
__device__ __forceinline__ float bf_lo(unsigned w) { return __uint_as_float(w << 16); }
__device__ __forceinline__ float bf_hi(unsigned w) { return __uint_as_float(w & 0xffff0000u); }
__device__ __forceinline__ float wave_sum(float v) {
#pragma unroll
    for (int o = 1; o < 64; o <<= 1) v += __shfl_xor(v, o);
    return v;
}
__device__ __forceinline__ float sigmoidf_(float x) { return 1.0f / (1.0f + __expf(-x)); }

namespace pg8 {
constexpr int BM = 256, BK = 64, HALF = 128, HTB = HALF * BK * 2, STAGE_BYTES = 8 * HTB, NXCD = 8, WGM = 8;
__host__ __device__ __forceinline__ int lds_byte(int r, int c) { const int st = (r >> 4) * 2 + (c >> 5), rr = r & 15, cc = c & 31, ob = rr * 64 + cc * 2; return st * 1024 + (ob ^ (((ob >> 9) & 1) << 5)); }
__host__ __device__ __forceinline__ void stage_rc(int b, int& R, int& C) { const int st = b / 1024, sb = b % 1024, swz = sb ^ (((sb >> 9) & 1) << 5); R = (st >> 1) * 16 + swz / 64; C = (st & 1) * 32 + (swz % 64) / 2; }
__host__ __device__ __forceinline__ int perm32(int rho) { const int n = rho >> 4, i = rho & 15; return 8 * (i >> 2) + 4 * n + (i & 3); }

struct Unit { int pm, pn, s; };

struct StaticOrder {
    int nM, nN, nwg, G, c;
    __device__ __forceinline__ void init(int M_, int N_, int G_, int c_) { nM = M_ / BM; nN = N_ / BM; nwg = nM * nN; G = G_; c = c_; }
    __device__ __forceinline__ bool next(int i, Unit& u) const {
        const long L = (long)i * G + c; if (L >= nwg) return false;
        int wgid = (int)L; { const int q = nwg / NXCD, r = nwg % NXCD, xcd = wgid % NXCD, off = wgid / NXCD; wgid = (xcd < r ? xcd * (q + 1) : r * (q + 1) + (xcd - r) * q) + off; }
        const int nig = WGM * nN, gid = wgid / nig, fm = gid * WGM, gsz = (nM - fm) < WGM ? (nM - fm) : WGM;
        u.pm = fm + ((wgid % nig) % gsz); u.pn = (wgid % nig) / gsz; u.s = 0; return true;
    }
    __device__ __forceinline__ bool is_short() const { return (nwg % G) != 0 && c >= (nwg % G); }
};
struct PairOrder : StaticOrder {
    __device__ __forceinline__ bool next(int i, Unit& u) const { const bool ok = StaticOrder::next(i >> 1, u); u.s = i & 1; return ok; }
};

template <class Epi, class Sched, class Ops>
__device__ __forceinline__ void gemm_phase(LAS unsigned char* lds, const Ops& P, const int K, const Sched& S, const Epi& E, const unsigned stagger_ticks = 0) {
    if (stagger_ticks && S.is_short()) { const unsigned long long t0_ = __builtin_amdgcn_s_memrealtime(); while (__builtin_amdgcn_s_memrealtime() - t0_ < stagger_ticks) __builtin_amdgcn_s_sleep(8); }
    int tid = threadIdx.x; asm volatile("" : "+v"(tid));
    const int wid = __builtin_amdgcn_readfirstlane(tid >> 6), lane = tid & 63, wr = wid >> 2, wc = wid & 3, fr = lane & 15, fq = lane >> 4;
    const int nt = K / BK;
    unsigned voffA[2], voffB[2];
#pragma unroll
    for (int i = 0; i < 2; ++i) { int R, C; stage_rc(tid * 16 + i * 8192, R, C); const int Rb = Epi::PERM ? ((R & ~31) + perm32(R & 31)) : R;
        voffA[i] = (unsigned)(R * K + C) * 2u; voffB[i] = (unsigned)(Rb * K + C) * 2u; }
    const size_t kstep = (size_t)(BK * 2);
    const size_t hstep = (size_t)HALF * K * 2;
    const unsigned ldsw = (unsigned)wid * 1024u;
    const int aoff = lds_byte(wr * 64 + fr, fq * 8), boff = lds_byte(wc * 32 + fr, fq * 8);
#define PG8_SA(b, h) (((b) * 2 + (h)) * HTB)
#define PG8_SB(b, h) ((4 + (b) * 2 + (h)) * HTB)
#define PG8_STAGE(bufoff, gbase, voff) do { _Pragma("unroll") for (int _i = 0; _i < 2; ++_i) \
        __builtin_amdgcn_global_load_lds((const unsigned*)((const char*)(gbase) + (voff)[_i]), (LAS unsigned*)(lds + (bufoff) + ldsw + _i * 8192), 16, 0, 0); } while (0)
#define PG8_LDA(dst, b, h) do { _Pragma("unroll") for (int m = 0; m < 4; ++m) _Pragma("unroll") for (int k = 0; k < 2; ++k) dst[m][k] = *(const LAS bf16x8*)(lds + PG8_SA(b, h) + aoff + m * 2048 + k * 1024); } while (0)
#define PG8_LDB(dst, b, h) do { _Pragma("unroll") for (int n = 0; n < 2; ++n) _Pragma("unroll") for (int k = 0; k < 2; ++k) dst[n][k] = *(const LAS bf16x8*)(lds + PG8_SB(b, h) + boff + n * 2048 + k * 1024); } while (0)
#define PG8_MMA(ai, bj, At, Bt) do { __builtin_amdgcn_s_setprio(1); _Pragma("unroll") for (int m = 0; m < 4; ++m) _Pragma("unroll") for (int n = 0; n < 2; ++n) _Pragma("unroll") for (int k = 0; k < 2; ++k) \
        acc[ai][bj][m][n] = __builtin_amdgcn_mfma_f32_16x16x32_bf16(Bt[n][k], At[m][k], acc[ai][bj][m][n], 0, 0, 0); __builtin_amdgcn_s_setprio(0); } while (0)
#define PG8_WAIT_V(n) asm volatile("s_waitcnt vmcnt(" #n ")" ::: "memory")
#define PG8_WAIT_L(n) asm volatile("s_waitcnt lgkmcnt(" #n ")" ::: "memory")
#define PG8_BAR __builtin_amdgcn_s_barrier()
#define PG8_SCHED __builtin_amdgcn_sched_barrier(0)
    Unit cur, nxt; int ui = 0;
    if (!S.next(0, cur)) return;
    f32x4 acc[2][2][4][2];
#pragma unroll
    for (int a = 0; a < 2; ++a)
#pragma unroll
        for (int b = 0; b < 2; ++b)
#pragma unroll
            for (int m = 0; m < 4; ++m)
#pragma unroll
                for (int n = 0; n < 2; ++n) acc[a][b][m][n] = (f32x4){0.f, 0.f, 0.f, 0.f};
    bf16x8 At[4][2], B0[2][2], B1[2][2];
    const char* cA = P.a_base(cur); const char* cB = P.b_base(cur);
    PG8_STAGE(PG8_SB(0, 0), cB, voffB); PG8_STAGE(PG8_SB(0, 1), cB + hstep, voffB); PG8_STAGE(PG8_SA(0, 0), cA, voffA); PG8_STAGE(PG8_SA(0, 1), cA + hstep, voffA);
    if (wr == 1) PG8_BAR;
    PG8_WAIT_V(2); PG8_BAR;
    PG8_STAGE(PG8_SB(1, 0), cB + kstep, voffB); PG8_STAGE(PG8_SA(1, 0), cA + kstep, voffA); PG8_STAGE(PG8_SB(1, 1), cB + hstep + kstep, voffB);
    PG8_WAIT_V(6); PG8_BAR;
    for (;;) {
        const bool has_next = S.next(ui + 1, nxt);
        const char* nA = has_next ? P.a_base(nxt) : cA; const char* nB = has_next ? P.b_base(nxt) : cB;
        for (int t = 0; t < nt; t += 2) {
            const bool last = (t == nt - 2);
            const char* a1 = cA + (size_t)(t + 1) * kstep;
            const char* a2 = last ? nA : cA + (size_t)(t + 2) * kstep; const char* b2 = last ? nB : cB + (size_t)(t + 2) * kstep;
            const char* a3 = a2 + kstep; const char* b3 = b2 + kstep;
            PG8_LDB(B0, 0, 0); PG8_LDB(B1, 0, 1); PG8_SCHED; PG8_LDA(At, 0, 0); PG8_STAGE(PG8_SA(1, 1), a1 + hstep, voffA);
            PG8_WAIT_V(8); PG8_WAIT_L(0); PG8_BAR; PG8_MMA(0, 0, At, B0); PG8_MMA(0, 1, At, B1); PG8_BAR; PG8_SCHED;
            PG8_LDA(At, 0, 1); PG8_STAGE(PG8_SB(0, 0), b2, voffB); PG8_STAGE(PG8_SB(0, 1), b2 + hstep, voffB); PG8_STAGE(PG8_SA(0, 0), a2, voffA);
            PG8_WAIT_V(8); PG8_WAIT_L(0); PG8_BAR; PG8_MMA(1, 0, At, B0); PG8_MMA(1, 1, At, B1); PG8_BAR; PG8_SCHED;
            PG8_LDB(B0, 1, 0); PG8_LDB(B1, 1, 1); PG8_SCHED; PG8_LDA(At, 1, 0); PG8_STAGE(PG8_SA(0, 1), a2 + hstep, voffA);
            PG8_WAIT_V(8); PG8_WAIT_L(0); PG8_BAR; PG8_MMA(0, 0, At, B0); PG8_MMA(0, 1, At, B1); PG8_BAR; PG8_SCHED;
            PG8_LDA(At, 1, 1); PG8_STAGE(PG8_SB(1, 0), b3, voffB); PG8_STAGE(PG8_SB(1, 1), b3 + hstep, voffB); PG8_STAGE(PG8_SA(1, 0), a3, voffA);
            PG8_WAIT_V(8); PG8_WAIT_L(0); PG8_BAR; PG8_MMA(1, 0, At, B0); PG8_MMA(1, 1, At, B1); PG8_BAR; PG8_SCHED;
        }
        if (wr == 0) PG8_BAR;
        E(acc, cur, wr, wc, fr, fq);
        if (!has_next) break;
        if (!E.keep(cur)) {
#pragma unroll
            for (int a = 0; a < 2; ++a)
#pragma unroll
                for (int b = 0; b < 2; ++b)
#pragma unroll
                    for (int m = 0; m < 4; ++m)
#pragma unroll
                        for (int n = 0; n < 2; ++n) acc[a][b][m][n] = (f32x4){0.f, 0.f, 0.f, 0.f};
        }
        cur = nxt; cA = nA; cB = nB; ++ui;
        if (wr == 1) PG8_BAR;
    }
    PG8_WAIT_V(0);
    PG8_BAR;
#undef PG8_SA
#undef PG8_SB
#undef PG8_STAGE
#undef PG8_LDA
#undef PG8_LDB
#undef PG8_MMA
#undef PG8_WAIT_V
#undef PG8_WAIT_L
#undef PG8_BAR
#undef PG8_SCHED
}
}

struct OpsPlain { const char* A; const char* Bt; size_t tstep;
    __device__ __forceinline__ const char* a_base(const pg8::Unit& u) const { return A + (size_t)u.pm * tstep; }
    __device__ __forceinline__ const char* b_base(const pg8::Unit& u) const { return Bt + (size_t)u.pn * tstep; } };
struct OpsPair { const char* A0; long dA; const char* B0; long dB; size_t tstep;
    __device__ __forceinline__ const char* a_base(const pg8::Unit& u) const { return A0 + (long)u.s * dA + (size_t)u.pm * tstep; }
    __device__ __forceinline__ const char* b_base(const pg8::Unit& u) const { return B0 + (long)u.s * dB + (size_t)u.pn * tstep; } };


struct EpiIn {
    static constexpr bool PERM = true;
    unsigned char* ws; float* out; const float *qg, *kg;
    __device__ __forceinline__ bool keep(const pg8::Unit&) const { return false; }
    __device__ __forceinline__ void operator()(f32x4 (&acc)[2][2][4][2], const pg8::Unit& u, int wr, int wc, int fr, int fq) const {
        const int pn = u.pn, pm = u.pm; const bool prompt = pm < 32;
        int kind, hcol;
        if (pn < 2) { kind = 0; hcol = (4 * pn + wc) * 64; }
        else if (pn == 2) { if (wc < 2) { kind = 1; hcol = wc * 64; } else { kind = 2; hcol = (wc - 2) * 64; } }
        else if (pn < 5) { kind = 3; hcol = (4 * (pn - 3) + wc) * 64; }
        else if (pn < 7) { kind = 4; hcol = (4 * (pn - 5) + wc) * 64; }
        else if (pn < 9) { kind = 5; hcol = (4 * (pn - 7) + wc) * 64; }
        else if (pn < 13) { kind = 6; hcol = 256 * (pn - 9) + 64 * wc; }
        else { kind = 7; hcol = 256 * (pn - 13) + 64 * wc; }
        bf16_t* dst; int pitch; float* fo = nullptr; bool kvdst = false;
        switch (kind) {
            case 0: dst = (bf16_t*)(ws + WS_QA); pitch = 512; break;
            case 1: dst = (bf16_t*)(ws + WS_KA); pitch = 128; kvdst = true; fo = out + OUT_AK; break;
            case 2: dst = (bf16_t*)(ws + WS_VA); pitch = 128; kvdst = true; fo = out + OUT_AV; break;
            case 3: dst = (bf16_t*)(ws + WS_QB); pitch = 512; break;
            case 4: dst = (bf16_t*)(ws + WS_KB); pitch = 512; kvdst = true; fo = out + OUT_BK; break;
            case 5: dst = (bf16_t*)(ws + WS_VB); pitch = 512; kvdst = true; fo = out + OUT_BV; break;
            case 6: dst = (bf16_t*)(ws + WS_GA); pitch = 1024; break;
            default: dst = (bf16_t*)(ws + WS_GB); pitch = 1024; break;
        }
        const float* ropec = (const float*)(ws + WS_ROPE); const float* ropes = ropec + 1024;
        const bool norm = kind <= 1, rope = norm && !prompt;
        const float qscale = (kind == 0 || kind == 3) ? C2 : 1.0f;
        const int lb = prompt ? 0 : ((pm - 32) >> 4), tb = prompt ? 0 : ((pm - 32) & 15);
        const long rowadd = kvdst ? (prompt ? (long)NBS * KVL : (long)(-MP) + 512L * (lb + 1)) : 0L;
        const float* gsel = ((kind == 0) ? qg : kg) + 8 * fq;
        const int i0 = 8 * (fq & 1);
#pragma unroll
        for (int ai = 0; ai < 2; ++ai) {
            const int grow = 4 * tb + 2 * ai + wr;
#pragma unroll
            for (int m = 0; m < 4; ++m) {
                const int rt = ai * 128 + wr * 64 + m * 16 + fr; const long row = (long)pm * 256 + rt;
                f32x4 v[2][2];
#pragma unroll
                for (int bj = 0; bj < 2; ++bj)
#pragma unroll
                    for (int n = 0; n < 2; ++n) v[bj][n] = acc[ai][bj][m][n];
                if (norm) {
                    float ss = 0.f;
#pragma unroll
                    for (int bj = 0; bj < 2; ++bj)
#pragma unroll
                        for (int n = 0; n < 2; ++n) ss += (v[bj][n][0] * v[bj][n][0] + v[bj][n][1] * v[bj][n][1]) + (v[bj][n][2] * v[bj][n][2] + v[bj][n][3] * v[bj][n][3]);
                    ss += __shfl_xor(ss, 16); ss += __shfl_xor(ss, 32);
                    const float inv = 1.0f / sqrtf(ss * (1.0f / 64.0f) + RMS_EPS);
#pragma unroll
                    for (int bj = 0; bj < 2; ++bj)
#pragma unroll
                        for (int n = 0; n < 2; ++n) v[bj][n] = (v[bj][n] * inv) * *(const f32x4*)(gsel + 32 * bj + 4 * n);
                }
                if (fo && prompt) {
                    float* fp = fo + (size_t)row * pitch + hcol + 8 * fq;
#pragma unroll
                    for (int bj = 0; bj < 2; ++bj)
#pragma unroll
                        for (int n = 0; n < 2; ++n) *(f32x4*)(fp + 32 * bj + 4 * n) = v[bj][n];
                }
                if (rope) {
                    const int gcol = m * 16 + fr;
#pragma unroll
                    for (int bj = 0; bj < 2; ++bj) {
                        const float* tc = ropec + (bj ? gcol : grow) * 16 + i0; const float* ts = ropes + (bj ? gcol : grow) * 16 + i0;
#pragma unroll
                        for (int n = 0; n < 2; ++n) {
                            const f32x4 co = *(const f32x4*)(tc + 4 * n), si = *(const f32x4*)(ts + 4 * n);
                            f32x4 o;
#pragma unroll
                            for (int e = 0; e < 4; ++e) { const float mine = v[bj][n][e], oth = __shfl_xor(mine, 32);
                                o[e] = (fq < 2) ? (mine * co[e] - oth * si[e]) : (oth * si[e] + mine * co[e]); }
                            v[bj][n] = o;
                        }
                    }
                }
                bf16_t* dp = dst + (size_t)(row + rowadd) * pitch + hcol + 8 * fq;
#pragma unroll
                for (int bj = 0; bj < 2; ++bj) {
                    f32x4 a = v[bj][0], b = v[bj][1];
                    if (kind >= 6) {
#pragma unroll
                        for (int e = 0; e < 4; ++e) { a[e] = sigmoidf_(a[e]); b[e] = sigmoidf_(b[e]); }
                    } else { a = a * qscale; b = b * qscale; }
                    u32x4 w; w.x = cvt_pk_bf16(a[0], a[1]); w.y = cvt_pk_bf16(a[2], a[3]); w.z = cvt_pk_bf16(b[0], b[1]); w.w = cvt_pk_bf16(b[2], b[3]);
                    *(u32x4*)(dp + 32 * bj) = w;
                }
                asm volatile("" ::: "memory");
            }
        }
    }
};

struct EpiBr {
    static constexpr bool PERM = true;
    const bf16_t *GA, *GB; bf16_t* MMo;
    __device__ __forceinline__ bool keep(const pg8::Unit& u) const { return u.s == 0; }
    __device__ __forceinline__ void operator()(f32x4 (&acc)[2][2][4][2], const pg8::Unit& u, int wr, int wc, int fr, int fq) const {
        const int col0 = u.pn * 256 + wc * 32 + 8 * fq;
#pragma unroll
        for (int ai = 0; ai < 2; ++ai)
#pragma unroll
            for (int m = 0; m < 4; ++m) { const size_t row = (size_t)u.pm * 256 + ai * 128 + wr * 64 + m * 16 + fr;
#pragma unroll
                for (int bj = 0; bj < 2; ++bj) { const size_t off = row * 1024 + col0 + bj * 128;
                    const u32x4 gb = *(const u32x4*)(GB + off);
                    const f32x4 sb0 = {bf_lo(gb.x), bf_hi(gb.x), bf_lo(gb.y), bf_hi(gb.y)}, sb1 = {bf_lo(gb.z), bf_hi(gb.z), bf_lo(gb.w), bf_hi(gb.w)};
                    if (u.s == 0) {
                        const u32x4 ga = *(const u32x4*)(GA + off);
                        const f32x4 sa0 = {bf_lo(ga.x), bf_hi(ga.x), bf_lo(ga.y), bf_hi(ga.y)}, sa1 = {bf_lo(ga.z), bf_hi(ga.z), bf_lo(ga.w), bf_hi(ga.w)};
                        acc[ai][bj][m][0] = acc[ai][bj][m][0] * (sa0 / sb0); acc[ai][bj][m][1] = acc[ai][bj][m][1] * (sa1 / sb1);
                    } else {
                        const f32x4 o0 = acc[ai][bj][m][0] * sb0, o1 = acc[ai][bj][m][1] * sb1;
                        u32x4 w; w.x = cvt_pk_bf16(o0[0], o0[1]); w.y = cvt_pk_bf16(o0[2], o0[3]); w.z = cvt_pk_bf16(o1[0], o1[1]); w.w = cvt_pk_bf16(o1[2], o1[3]);
                        *(u32x4*)(MMo + off) = w;
                    }
                }
                asm volatile("" ::: "memory"); }
    }
};

struct EpiOut {
    static constexpr bool PERM = false;
    const float *xp, *xs, *mod, *n2; float* x1; bf16_t* XW; float* ssq;
    __device__ __forceinline__ bool keep(const pg8::Unit&) const { return false; }
    __device__ __forceinline__ void operator()(f32x4 (&acc)[2][2][4][2], const pg8::Unit& u, int wr, int wc, int fr, int fq) const {
        const int pm = u.pm; const bool prompt = pm < 32; const int mrow = prompt ? 8 : ((pm - 32) >> 4);
        const float* modr = mod + (size_t)mrow * NMOD; const int col0 = u.pn * 256 + wc * 32 + 4 * fq;
        const float* xbase = prompt ? xp : (xs - (size_t)MP * DM);
        f32x4 g1[2][2], w2[2][2];
#pragma unroll
        for (int bj = 0; bj < 2; ++bj)
#pragma unroll
            for (int n = 0; n < 2; ++n) { const int c = col0 + bj * 128 + n * 16; g1[bj][n] = *(const f32x4*)(modr + 2048 + c);
                const f32x4 sc = *(const f32x4*)(modr + 4096 + c), nn = *(const f32x4*)(n2 + c); w2[bj][n] = nn * (sc + 1.0f); }
#pragma unroll
        for (int ai = 0; ai < 2; ++ai)
#pragma unroll
            for (int m = 0; m < 4; ++m) { const size_t row = (size_t)pm * 256 + ai * 128 + wr * 64 + m * 16 + fr; float ss = 0.f;
#pragma unroll
                for (int bj = 0; bj < 2; ++bj)
#pragma unroll
                    for (int n = 0; n < 2; ++n) { const size_t off = row * DM + col0 + bj * 128 + n * 16;
                        const f32x4 xv = *(const f32x4*)(xbase + off); const f32x4 o = xv + g1[bj][n] * acc[ai][bj][m][n];
                        *(f32x4*)(x1 + off) = o; ss += (o[0] * o[0] + o[1] * o[1]) + (o[2] * o[2] + o[3] * o[3]);
                        const f32x4 ow = o * w2[bj][n]; u32x2 w; w.x = cvt_pk_bf16(ow[0], ow[1]); w.y = cvt_pk_bf16(ow[2], ow[3]); *(u32x2*)(XW + off) = w; }
                ss += __shfl_xor(ss, 16); ss += __shfl_xor(ss, 32);
                if (fq == 0) ssq[row * 16 + u.pn * 4 + wc] = ss; }
    }
};

struct EpiUp {
    static constexpr bool PERM = true;
    const float *ssq, *bup; bf16_t* HID;
    __device__ __forceinline__ bool keep(const pg8::Unit&) const { return false; }
    __device__ __forceinline__ void operator()(f32x4 (&acc)[2][2][4][2], const pg8::Unit& u, int wr, int wc, int fr, int fq) const {
        const int pm = u.pm; const int mrow = pm < 32 ? 8 : ((pm - 32) >> 4); const int col0 = u.pn * 256 + wc * 32 + 8 * fq;
        f32x4 bv[2][2];
#pragma unroll
        for (int bj = 0; bj < 2; ++bj)
#pragma unroll
            for (int n = 0; n < 2; ++n) bv[bj][n] = *(const f32x4*)(bup + (size_t)mrow * FF + col0 + bj * 128 + 4 * n);
#pragma unroll
        for (int ai = 0; ai < 2; ++ai)
#pragma unroll
            for (int m = 0; m < 4; ++m) { const size_t row = (size_t)pm * 256 + ai * 128 + wr * 64 + m * 16 + fr;
                const f32x4* sp = (const f32x4*)(ssq + row * 16); const f32x4 s0 = sp[0], s1 = sp[1], s2 = sp[2], s3 = sp[3];
                const float tot = (((s0[0] + s0[1]) + (s0[2] + s0[3])) + ((s1[0] + s1[1]) + (s1[2] + s1[3]))) + (((s2[0] + s2[1]) + (s2[2] + s2[3])) + ((s3[0] + s3[1]) + (s3[2] + s3[3])));
                const float inv = 1.0f / sqrtf(tot * (1.0f / DM) + RMS_EPS);
#pragma unroll
                for (int bj = 0; bj < 2; ++bj) { f32x4 a = acc[ai][bj][m][0] * inv + bv[bj][0], b = acc[ai][bj][m][1] * inv + bv[bj][1];
#pragma unroll
                    for (int e = 0; e < 4; ++e) { a[e] = fmaxf(a[e], 0.f); a[e] *= a[e]; b[e] = fmaxf(b[e], 0.f); b[e] *= b[e]; }
                    u32x4 w; w.x = cvt_pk_bf16(a[0], a[1]); w.y = cvt_pk_bf16(a[2], a[3]); w.z = cvt_pk_bf16(b[0], b[1]); w.w = cvt_pk_bf16(b[2], b[3]);
                    *(u32x4*)(HID + row * FF + col0 + bj * 128) = w; } }
    }
};

struct EpiDown {
    static constexpr bool PERM = false;
    const float* mod; float* x1;
    __device__ __forceinline__ bool keep(const pg8::Unit&) const { return false; }
    __device__ __forceinline__ void operator()(f32x4 (&acc)[2][2][4][2], const pg8::Unit& u, int wr, int wc, int fr, int fq) const {
        const int pm = u.pm; const int mrow = pm < 32 ? 8 : ((pm - 32) >> 4); const float* modr = mod + (size_t)mrow * NMOD; const int col0 = u.pn * 256 + wc * 32 + 4 * fq;
        f32x4 g2[2][2];
#pragma unroll
        for (int bj = 0; bj < 2; ++bj)
#pragma unroll
            for (int n = 0; n < 2; ++n) g2[bj][n] = *(const f32x4*)(modr + 5120 + col0 + bj * 128 + n * 16);
#pragma unroll
        for (int ai = 0; ai < 2; ++ai)
#pragma unroll
            for (int m = 0; m < 4; ++m) { const size_t row = (size_t)pm * 256 + ai * 128 + wr * 64 + m * 16 + fr;
#pragma unroll
                for (int bj = 0; bj < 2; ++bj)
#pragma unroll
                    for (int n = 0; n < 2; ++n) { const size_t off = row * DM + col0 + bj * 128 + n * 16;
                        const f32x4 xv = *(const f32x4*)(x1 + off); *(f32x4*)(x1 + off) = xv + g2[bj][n] * acc[ai][bj][m][n]; }
                if (m & 1) asm volatile("" ::: "memory"); }
    }
};

namespace attn_body {
using bf16 = __hip_bfloat16;
using s16x4 = __attribute__((ext_vector_type(4))) short;
using f32x16 = __attribute__((ext_vector_type(16))) float;
constexpr int D = 64, NW = 8, QBLK = 32, QB = QBLK * NW, KVBLK = 64;
__device__ __forceinline__ int crow(int r, int hi) { return (r & 3) + 8 * (r >> 2) + 4 * hi; }
#define SBAR() __builtin_amdgcn_sched_barrier(0)
constexpr int NSLOT = 3, SLOTB = 8192;
constexpr int LDS_K = 0, LDS_V = NSLOT * SLOTB, LDS_WS = 2 * NSLOT * SLOTB, LDS_OST = LDS_WS + NW * 64 * 4, LDS_BYTES = LDS_OST + NW * 4096;
constexpr int LDS_MASK = 120320;
constexpr int LDS_TAB = 86016;
__device__ __forceinline__ void glds16(const void* sbase, unsigned voff, unsigned lds_dst) { unsigned keep;
    asm volatile("s_nop 4\n\ts_mov_b32 %0, m0\n\ts_mov_b32 m0, %3\n\ts_nop 0\n\tglobal_load_lds_dwordx4 %1, %2\n\ts_mov_b32 m0, %0" : "=&s"(keep) : "v"(voff), "s"(sbase), "s"(lds_dst) : "memory"); }
__device__ __forceinline__ float max3f(float a, float b, float c) { float r; asm("v_max3_f32 %0, %1, %2, %3" : "=v"(r) : "v"(a), "v"(b), "v"(c)); return r; }
__device__ __forceinline__ float max2f(float a, float b) { float r; asm("v_max_f32_e32 %0, %1, %2" : "=v"(r) : "v"(a), "v"(b)); return r; }
__device__ __forceinline__ float fadd_s(float a, float b) { float r; asm("v_add_f32_e32 %0, %1, %2" : "=v"(r) : "v"(a), "v"(b)); return r; }
__device__ __forceinline__ float fsub_s(float a, float b) { float r; asm("v_sub_f32_e32 %0, %1, %2" : "=v"(r) : "v"(a), "v"(b)); return r; }
typedef float f32x2_t __attribute__((ext_vector_type(2))); typedef __bf16 bf16x2_t __attribute__((ext_vector_type(2)));
__device__ __forceinline__ unsigned cvtpk_s(float lo, float hi) { f32x2_t v = {lo, hi}; bf16x2_t b = __builtin_convertvector(v, bf16x2_t); return __builtin_bit_cast(unsigned, b); }
#define WAIT_BAR(N) asm volatile("s_waitcnt vmcnt(" #N ") lgkmcnt(0)\n\ts_barrier" ::: "memory")

__device__ __forceinline__ void qkt(f32x16& p0, f32x16& p1, const char* Kslot, const bf16x8* qr, const f32x16& negm, int r32, int hi) {
    const char* kb = Kslot + hi * 1024 + r32 * 16;
#pragma unroll
    for (int d0 = 0; d0 < 4; ++d0) {
        const bf16x8 b0 = *reinterpret_cast<const bf16x8*>(kb + d0 * 2048);
        const bf16x8 b1 = *reinterpret_cast<const bf16x8*>(kb + d0 * 2048 + 512);
        if (d0 == 0) { p0 = __builtin_amdgcn_mfma_f32_32x32x16_bf16(b0, qr[0], negm, 0, 0, 0); p1 = __builtin_amdgcn_mfma_f32_32x32x16_bf16(b1, qr[0], negm, 0, 0, 0); }
        else { p0 = __builtin_amdgcn_mfma_f32_32x32x16_bf16(b0, qr[d0], p0, 0, 0, 0); p1 = __builtin_amdgcn_mfma_f32_32x32x16_bf16(b1, qr[d0], p1, 0, 0, 0); } }
}
typedef __attribute__((address_space(3))) const char* lds_cptr;
typedef short v4i16_t __attribute__((ext_vector_type(4)));
__device__ __forceinline__ void kload8(bf16x8* kf, lds_cptr kp) {
    kf[0] = *(const LAS bf16x8*)(kp);        kf[1] = *(const LAS bf16x8*)(kp + 512);
    kf[2] = *(const LAS bf16x8*)(kp + 2048); kf[3] = *(const LAS bf16x8*)(kp + 2560);
    kf[4] = *(const LAS bf16x8*)(kp + 4096); kf[5] = *(const LAS bf16x8*)(kp + 4608);
    kf[6] = *(const LAS bf16x8*)(kp + 6144); kf[7] = *(const LAS bf16x8*)(kp + 6656);
}
__device__ __forceinline__ void kload2(bf16x8* kf, lds_cptr kp, int j) { kf[2 * j] = *(const LAS bf16x8*)(kp + j * 2048); kf[2 * j + 1] = *(const LAS bf16x8*)(kp + j * 2048 + 512); }
__device__ __forceinline__ s16x4 vtr(lds_cptr p) { return __builtin_bit_cast(s16x4, __builtin_amdgcn_ds_read_tr16_b64_v4i16((LAS v4i16_t*)p)); }
__device__ __forceinline__ float rowmax(const f32x16& p0, const f32x16& p1) {
    float a = max3f(p0[0], p0[1], p1[0]), b = max3f(p0[2], p0[3], p1[1]); a = max3f(a, p1[2], p1[3]);
#pragma unroll
    for (int r = 4; r < 16; r += 4) { a = max3f(a, p0[r], p0[r + 1]); b = max3f(b, p0[r + 2], p0[r + 3]); a = max3f(a, p1[r], p1[r + 1]); b = max3f(b, p1[r + 2], p1[r + 3]); }
    const float m = max2f(a, b);
    auto rr = __builtin_amdgcn_permlane32_swap(__float_as_uint(m), __float_as_uint(m), false, false);
    return max2f(__uint_as_float(rr[0]), __uint_as_float(rr[1]));
}
__device__ __forceinline__ void pv(f32x16* o, int vb, bf16x8 pa0, bf16x8 pa1, bf16x8 pa2, bf16x8 pa3) {
#pragma unroll
    for (int d0 = 0; d0 < 2; ++d0) { s16x4 lo[4], hi[4];
#pragma unroll
        for (int ks = 0; ks < 4; ++ks) {
            asm volatile("ds_read_b64_tr_b16 %0,%1 offset:%c2" : "=&v"(lo[ks]) : "v"(vb), "i"(d0 * 4096 + ks * 1024) : "memory");
            asm volatile("ds_read_b64_tr_b16 %0,%1 offset:%c2" : "=&v"(hi[ks]) : "v"(vb), "i"(d0 * 4096 + ks * 1024 + 512) : "memory"); }
        asm volatile("s_waitcnt lgkmcnt(0)" ::: "memory"); SBAR();
#define PK(k) (bf16x8){lo[k][0], lo[k][1], lo[k][2], lo[k][3], hi[k][0], hi[k][1], hi[k][2], hi[k][3]}
        o[d0] = __builtin_amdgcn_mfma_f32_32x32x16_bf16(pa0, PK(0), o[d0], 0, 0, 0);
        o[d0] = __builtin_amdgcn_mfma_f32_32x32x16_bf16(pa1, PK(1), o[d0], 0, 0, 0);
        o[d0] = __builtin_amdgcn_mfma_f32_32x32x16_bf16(pa2, PK(2), o[d0], 0, 0, 0);
        o[d0] = __builtin_amdgcn_mfma_f32_32x32x16_bf16(pa3, PK(3), o[d0], 0, 0, 0);
#undef PK
    }
}

struct AttnDesc { const bf16* Qw0; bf16* Ow0; const bf16* Kh; const bf16* Vh; int qp, kp, NT, lo, qrow0; };

constexpr int TABR = 132, TABC = 2128;
constexpr int MSKR = 68;
template <int HK> __device__ __forceinline__ void nb_hook(f32x16& C0, f32x16& C1, int t, int lo, int qrow, int qc, int hi, float mhat, const LAS float* tab, const LAS float* maskT) {
    if (HK == 0) {
#pragma unroll
        for (int r = 0; r < 16; ++r) { C0[r] -= mhat; C1[r] -= mhat; }
    } else {
        const int kr = lo + t - 8;
        int rs = qrow - 4; rs = rs < 0 ? 0 : (rs > 56 ? 56 : rs);
        const bool rowok = (kr >= rs && kr < rs + 8);
        const int dr = rowok ? (kr - qrow + 7) : 15;
        const LAS f32x4* bp = (const LAS f32x4*)(tab + (qc & 3) * (TABC + 1) + dr * TABR + (64 + 4 * hi - qc));
        const LAS f32x4* mp = (const LAS f32x4*)(maskT + (rowok ? qc : 64) * MSKR + 4 * hi);
        {   f32x4 b[4];
#pragma unroll
            for (int g = 0; g < 4; ++g) b[g] = bp[2 * g] + mp[2 * g];
#pragma unroll
            for (int g = 0; g < 4; ++g)
#pragma unroll
                for (int e = 0; e < 4; ++e) { const int r = 4 * g + e; C0[r] += b[g][e] - mhat; }
        }
        __builtin_amdgcn_sched_barrier(0);
        {   f32x4 b[4];
#pragma unroll
            for (int g = 0; g < 4; ++g) b[g] = bp[2 * g + 8] + mp[2 * g + 8];
#pragma unroll
            for (int g = 0; g < 4; ++g)
#pragma unroll
                for (int e = 0; e < 4; ++e) { const int r = 4 * g + e; C1[r] += b[g][e] - mhat; }
        }
    }
}

#define ATTN_STORE16(p, v) (*(u32x4*)(p) = (v))
template <int MODE, int THRL> __device__ __forceinline__ void attn_unit(const AttnDesc& ds, char* shm) {
    int tid = threadIdx.x; asm volatile("" : "+v"(tid));
    const int lane = tid & 63, r32 = lane & 31, hi = lane >> 5; const int wid = __builtin_amdgcn_readfirstlane(tid >> 6);
    const int qp = ds.qp, kp = ds.kp, NT = ds.NT, lo = ds.lo;
    const bf16* Qw = ds.Qw0 + (long)(wid * QBLK) * qp;
    const bf16* Kh = ds.Kh; const bf16* Vh = ds.Vh;
    const unsigned lds0 = (unsigned)(uintptr_t)shm;
    float* wsf = (float*)(shm + LDS_WS) + wid * 64;
#define KOFF(l_) ((unsigned)(((l_) * kp + wid * 8) * 2))
#define VOFF(l_) ((unsigned)(((16 * (wid & 3) + ((l_) >> 2)) * kp + (wid >> 2) * 32 + ((l_) & 3) * 8) * 2))
    const unsigned koff = KOFF(lane), voff = VOFF(lane);
    const unsigned kdst = lds0 + LDS_K + wid * 1024, vdst = lds0 + LDS_V + wid * 1024;
    const long tstride = (long)KVBLK * kp;
#define TROW(t) ((long)((t) + ((MODE == 1 && (t) >= 8) ? lo : 0)) * tstride)
#define LANE_FRESH() ({ int l_ = (int)__builtin_amdgcn_mbcnt_hi(~0u, __builtin_amdgcn_mbcnt_lo(~0u, 0u)); asm volatile("" : "+v"(l_)); l_; })
#define DMA_K(t, slot) glds16(Kh + TROW(t), (MODE == 1) ? KOFF(LANE_FRESH()) : koff, (unsigned)__builtin_amdgcn_readfirstlane(kdst + (slot)))
#define DMA_V(t, slot) glds16(Vh + TROW(t), (MODE == 1) ? VOFF(LANE_FRESH()) : voff, (unsigned)__builtin_amdgcn_readfirstlane(vdst + (slot)))
    const int vb0 = (int)(lds0 + LDS_V) + ((lane >> 4) & 1) * 32 + (lane & 3) * 8 + (4 * hi + ((lane & 15) >> 2)) * 64;
    const char* Kbase = shm + LDS_K; bf16x8 kf[8];
    const lds_cptr shm3 = (lds_cptr)shm; const lds_cptr kp0 = shm3 + LDS_K + hi * 1024 + r32 * 16; const lds_cptr vp0 = shm3 + LDS_V + ((lane >> 4) & 1) * 32 + (lane & 3) * 8 + (4 * hi + ((lane & 15) >> 2)) * 64;
    const LAS float* tab = (const LAS float*)(shm3 + LDS_TAB); const LAS float* maskT = (const LAS float*)(shm3 + LDS_MASK);
    const int qrow = ds.qrow0 + (wid >> 1), qc = (wid & 1) * 32 + r32;
    DMA_K(0, 0); DMA_V(0, 0); DMA_K(1, SLOTB);
    bf16x8 qr[4];
#pragma unroll
    for (int d0 = 0; d0 < 4; ++d0) qr[d0] = *reinterpret_cast<const bf16x8*>(&Qw[(long)r32 * qp + d0 * 16 + hi * 8]);
    float mhat = 0.f, l_reg = 0.f; f32x16 o[2]; o[0] = f32x16{}; o[1] = f32x16{}; f32x16 negm = f32x16{}; if (MODE == 0) asm volatile("" : "+v"(negm));
#define CMASK(P0, P1, t, HK) do { if (MODE == 1) nb_hook<HK>(P0, P1, (t), lo, qrow, qc, hi, mhat, tab, maskT); } while (0)
    bool resc = false;
#define START(P0, P1) do { const float rm = rowmax(P0, P1); resc = false; \
    { const float dl = rm; mhat = fadd_s(mhat, dl); \
      _Pragma("unroll") for (int r = 0; r < 16; ++r) { P0[r] = fsub_s(P0[r], dl); P1[r] = fsub_s(P1[r], dl); } \
      if (MODE == 0) { _Pragma("unroll") for (int r = 0; r < 16; ++r) negm[r] = -mhat; asm volatile("" : "+v"(negm)); } } \
    _Pragma("unroll") for (int r = 0; r < 16; ++r) P0[r] = __builtin_amdgcn_exp2f(P0[r]); } while (0)
#define RESC() do { if (resc) { asm volatile("s_waitcnt lgkmcnt(0)" ::: "memory"); \
      _Pragma("unroll") for (int d_ = 0; d_ < 2; ++d_) _Pragma("unroll") for (int r = 0; r < 16; ++r) o[d_][r] *= wsf[crow(r, hi)]; } } while (0)
    f32x16 pA0, pA1, pB0, pB1;
    int sl_prev = 0, sl_cur = 0, sl_next = SLOTB;
#define ROT() do { sl_prev = sl_cur; sl_cur = sl_next; sl_next = (sl_next == (NSLOT - 1) * SLOTB) ? 0 : sl_next + SLOTB; } while (0)
    DMA_K(2, 2 * SLOTB);
    WAIT_BAR(3);
    qkt(pA0, pA1, Kbase, qr, negm, r32, hi); asm volatile("s_nop 15\n\ts_nop 7" : "+v"(pA0), "+v"(pA1));
    START(pA0, pA1);
    _Pragma("unroll") for (int r = 0; r < 16; ++r) pA1[r] = __builtin_amdgcn_exp2f(pA1[r]);
    WAIT_BAR(0);
    DMA_K(3, 0); DMA_V(1, SLOTB);
    ROT();
    kload8(kf, kp0 + sl_cur);
    WAIT_BAR(2);
    s16x4 vlo[8], vhi[8]; u32x4 pw0, pw1, pw2, pw3;
#define PKW(P, B) cvtpk_s(P[B], P[B + 1])
#define PAF(k) __builtin_bit_cast(bf16x8, pw##k)
#define VFR(i) (bf16x8){vlo[i][0], vlo[i][1], vlo[i][2], vlo[i][3], vhi[i][0], vhi[i][1], vhi[i][2], vhi[i][3]}
#define PIN(x) asm volatile("" : "+v"(x))
#define MX3(a, b, c) __builtin_fmaxf(__builtin_fmaxf((a), (b)), (c))
#define GAPA(MF, A0, A1, A2, A3, W0, W1, PW) do { MF; sacc += A0; sacc += A1; sacc += A2; sacc += A3; PIN(sacc); W0; W1; PIN(PW); SBAR(); } while (0)
#define EX(v) __builtin_amdgcn_exp2f(v)
#define GAPB(MF, X, B) do { MF; X[B] = EX(X[B]); X[B + 1] = EX(X[B + 1]); X[B + 2] = EX(X[B + 2]); X[B + 3] = EX(X[B + 3]); PIN(X); SBAR(); } while (0)
#define VRD(i) do { vlo[i] = vtr(vp_ + (((i) >> 2) * 4096 + ((i) & 3) * 1024)); vhi[i] = vtr(vp_ + (((i) >> 2) * 4096 + ((i) & 3) * 1024 + 512)); } while (0)
#define KRD(G, j) do { if (G) { kload2(kf, kp0 + sl_next, j); SBAR(); } } while (0)
#define STEP(C0, C1, P0, P1, t, GK, GV, GL, HK) do { SBAR(); \
    const lds_cptr vp_ = vp0 + sl_prev; \
    VRD(0); SBAR(); float sacc = (P0[0] + P0[1]); \
    GAPA(C0 = __builtin_amdgcn_mfma_f32_32x32x16_bf16(kf[0], qr[0], negm, 0, 0, 0), P0[2], P0[3], P0[4], P0[5],     pw0[0] = PKW(P0, 0), pw0[1] = PKW(P0, 2), pw0); \
    VRD(4); SBAR(); GAPA(C1 = __builtin_amdgcn_mfma_f32_32x32x16_bf16(kf[1], qr[0], negm, 0, 0, 0), P0[6], P0[7], P0[8], P0[9],     pw0[2] = PKW(P0, 4), pw0[3] = PKW(P0, 6), pw0); \
    VRD(1); SBAR(); GAPA(C0 = __builtin_amdgcn_mfma_f32_32x32x16_bf16(kf[2], qr[1], C0, 0, 0, 0),   P0[10], P0[11], P0[12], P0[13], pw1[0] = PKW(P0, 8), pw1[1] = PKW(P0, 10), pw1); \
    VRD(5); SBAR(); GAPA(C1 = __builtin_amdgcn_mfma_f32_32x32x16_bf16(kf[3], qr[1], C1, 0, 0, 0),   P0[14], P0[15], P1[0], P1[1],   pw1[2] = PKW(P0, 12), pw1[3] = PKW(P0, 14), pw1); \
    VRD(2); SBAR(); GAPA(C0 = __builtin_amdgcn_mfma_f32_32x32x16_bf16(kf[4], qr[2], C0, 0, 0, 0),   P1[2], P1[3], P1[4], P1[5],     pw2[0] = PKW(P1, 0), pw2[1] = PKW(P1, 2), pw2); \
    VRD(6); SBAR(); GAPA(C1 = __builtin_amdgcn_mfma_f32_32x32x16_bf16(kf[5], qr[2], C1, 0, 0, 0),   P1[6], P1[7], P1[8], P1[9],     pw2[2] = PKW(P1, 4), pw2[3] = PKW(P1, 6), pw2); \
    VRD(3); SBAR(); GAPA(C0 = __builtin_amdgcn_mfma_f32_32x32x16_bf16(kf[6], qr[3], C0, 0, 0, 0),   P1[10], P1[11], P1[12], P1[13], pw3[0] = PKW(P1, 8), pw3[1] = PKW(P1, 10), pw3); \
    VRD(7); SBAR(); GAPA(C1 = __builtin_amdgcn_mfma_f32_32x32x16_bf16(kf[7], qr[3], C1, 0, 0, 0),   P1[14], P1[15], 0.f, 0.f,       pw3[2] = PKW(P1, 12), pw3[3] = PKW(P1, 14), pw3); \
    l_reg += sacc; \
    if (GK) { DMA_K((t) + 3, sl_cur); } if (GV) { DMA_V((t) + 1, sl_next); } \
    CMASK(C0, C1, t, HK); \
    { float a = MX3(C0[0], C0[1], C1[0]), b = MX3(C0[2], C0[3], C1[1]); a = MX3(a, C1[2], C1[3]); \
      _Pragma("unroll") for (int r = 4; r < 16; r += 4) { a = MX3(a, C0[r], C0[r + 1]); b = MX3(b, C0[r + 2], C0[r + 3]); a = MX3(a, C1[r], C1[r + 1]); b = MX3(b, C1[r + 2], C1[r + 3]); } \
      float rm = __builtin_fmaxf(a, b); { auto rr = __builtin_amdgcn_permlane32_swap(__float_as_uint(rm), __float_as_uint(rm), false, false); rm = __builtin_fmaxf(__uint_as_float(rr[0]), __uint_as_float(rr[1])); } \
      resc = false; \
      if (__builtin_expect(__any(rm > (float)THRL), 0)) { const float dl = __builtin_fmaxf(rm, 0.f); mhat += dl; \
        _Pragma("unroll") for (int r = 0; r < 16; ++r) { C0[r] -= dl; C1[r] -= dl; } \
        if (MODE == 0) { _Pragma("unroll") for (int r = 0; r < 16; ++r) negm[r] = -mhat; asm volatile("" : "+v"(negm)); } \
        const float f = __builtin_amdgcn_exp2f(-dl); l_reg *= f; if (hi == 0) wsf[r32] = f; resc = true; } } \
    SBAR(); \
    GAPB(o[0] = __builtin_amdgcn_mfma_f32_32x32x16_bf16(PAF(0), VFR(0), o[0], 0, 0, 0), C0, 0); \
    GAPB(o[1] = __builtin_amdgcn_mfma_f32_32x32x16_bf16(PAF(0), VFR(4), o[1], 0, 0, 0), C0, 4); \
    KRD(GL, 0); GAPB(o[0] = __builtin_amdgcn_mfma_f32_32x32x16_bf16(PAF(1), VFR(1), o[0], 0, 0, 0), C0, 8); \
    KRD(GL, 1); GAPB(o[1] = __builtin_amdgcn_mfma_f32_32x32x16_bf16(PAF(1), VFR(5), o[1], 0, 0, 0), C0, 12); \
    KRD(GL, 2); GAPB(o[0] = __builtin_amdgcn_mfma_f32_32x32x16_bf16(PAF(2), VFR(2), o[0], 0, 0, 0), C1, 0); \
    KRD(GL, 3); GAPB(o[1] = __builtin_amdgcn_mfma_f32_32x32x16_bf16(PAF(2), VFR(6), o[1], 0, 0, 0), C1, 4); \
    GAPB(o[0] = __builtin_amdgcn_mfma_f32_32x32x16_bf16(PAF(3), VFR(3), o[0], 0, 0, 0), C1, 8); \
    GAPB(o[1] = __builtin_amdgcn_mfma_f32_32x32x16_bf16(PAF(3), VFR(7), o[1], 0, 0, 0), C1, 12); \
    } while (0)
    int t = 1;
    if (MODE == 1) {
        for (; t < 7; t += 2) {
            STEP(pB0, pB1, pA0, pA1, t, true, true, true, 0);     WAIT_BAR(2); RESC(); ROT();
            STEP(pA0, pA1, pB0, pB1, t + 1, true, true, true, 0); WAIT_BAR(2); RESC(); ROT();
        }
        STEP(pB0, pB1, pA0, pA1, t, true, true, true, 0);     WAIT_BAR(2); RESC(); ROT();
        STEP(pA0, pA1, pB0, pB1, t + 1, true, true, true, 1); WAIT_BAR(2); RESC(); ROT();
        t += 2;
    }
    for (; t + 5 < NT; t += 2) {
        STEP(pB0, pB1, pA0, pA1, t, true, true, true, 1);     WAIT_BAR(2); RESC(); ROT();
        STEP(pA0, pA1, pB0, pB1, t + 1, true, true, true, 1); WAIT_BAR(2); RESC(); ROT();
    }
#define ENDW(tt) do { if ((tt) + 3 < NT) { WAIT_BAR(2); } else if ((tt) + 2 < NT) { WAIT_BAR(1); } else { WAIT_BAR(0); } } while (0)
    for (; t + 1 < NT; t += 2) {
        STEP(pB0, pB1, pA0, pA1, t, (t + 3 < NT), (t + 1 < NT), (t + 1 < NT), 1);     ENDW(t);     RESC(); ROT();
        STEP(pA0, pA1, pB0, pB1, t + 1, (t + 4 < NT), (t + 2 < NT), (t + 2 < NT), 1); ENDW(t + 1); RESC(); ROT();
    }
    STEP(pB0, pB1, pA0, pA1, NT - 1, false, false, false, 1); RESC();
    { float sacc = pB0[0] + pB0[1]; _Pragma("unroll") for (int r = 2; r < 16; ++r) sacc += pB0[r]; _Pragma("unroll") for (int r = 0; r < 16; ++r) sacc += pB1[r]; l_reg += sacc;
      pw0 = (u32x4){PKW(pB0, 0), PKW(pB0, 2), PKW(pB0, 4), PKW(pB0, 6)}; pw1 = (u32x4){PKW(pB0, 8), PKW(pB0, 10), PKW(pB0, 12), PKW(pB0, 14)}; pw2 = (u32x4){PKW(pB1, 0), PKW(pB1, 2), PKW(pB1, 4), PKW(pB1, 6)}; pw3 = (u32x4){PKW(pB1, 8), PKW(pB1, 10), PKW(pB1, 12), PKW(pB1, 14)};
      SBAR(); pv(o, vb0 + sl_cur, PAF(0), PAF(1), PAF(2), PAF(3)); }
#undef PKW
#undef PAF
#undef VFR
#undef PIN
#undef MX3
#undef GAPA
#undef GAPB
#undef EX
#undef VRD
#undef KRD
#undef STEP
#undef ENDW
    { auto rr = __builtin_amdgcn_permlane32_swap(__float_as_uint(l_reg), __float_as_uint(l_reg), false, false); l_reg = __uint_as_float(rr[0]) + __uint_as_float(rr[1]); }
    if (hi == 0) wsf[32 + r32] = l_reg; asm volatile("s_waitcnt lgkmcnt(0)" ::: "memory");
    float rli[16];
#pragma unroll
    for (int r = 0; r < 16; ++r) rli[r] = __builtin_amdgcn_rcpf(wsf[32 + crow(r, hi)]);
    bf16* Ow = ds.Ow0 + (long)(wid * QBLK) * qp;
    { bf16* stg = (bf16*)(shm + LDS_OST) + wid * 2048;
#pragma unroll
      for (int r = 0; r < 16; ++r) { const int orow = crow(r, hi);
#pragma unroll
          for (int d0 = 0; d0 < 2; ++d0) stg[orow * 64 + d0 * 32 + r32] = __float2bfloat16(o[d0][r] * rli[r]); }
      asm volatile("s_waitcnt lgkmcnt(0)" ::: "memory");
#pragma unroll
      for (int i = 0; i < 4; ++i) { const int row = i * 8 + (lane >> 3), ch = lane & 7; const u32x4 v = *(const u32x4*)(stg + row * 64 + ch * 8); ATTN_STORE16(Ow + (long)row * qp + ch * 8, v); } }
    asm volatile("s_waitcnt lgkmcnt(0)\n\ts_barrier" ::: "memory");
#undef DMA_K
#undef DMA_V
#undef LANE_FRESH
#undef KOFF
#undef VOFF
#undef TROW
#undef CMASK
#undef START
#undef RESC
#undef ROT
}
#undef SBAR
#undef WAIT_BAR
}

typedef GAS unsigned gu32;
#define RLX_AGENT __ATOMIC_RELAXED, __HIP_MEMORY_SCOPE_AGENT
#define XB_TMO      128
#define XB_XCNT(j)  (256  + 64 * (j))
#define XB_XSUB(j)  (1280 + 64 * (j))
#define XB_XGEN(j)  (2304 + 64 * (j))
#define XB_TOP      3328
#define XB_TOPGEN   3392
#define XCD_BAR_WORDS 3456
#define XB_SPIN_CAP (1u << 18)

__device__ __forceinline__ unsigned xb_ld(unsigned* p)              { return __hip_atomic_load(p, __ATOMIC_RELAXED, __HIP_MEMORY_SCOPE_AGENT); }
__device__ __forceinline__ unsigned xb_add(unsigned* p, unsigned v) { return __hip_atomic_fetch_add(p, v, __ATOMIC_RELAXED, __HIP_MEMORY_SCOPE_AGENT); }
__device__ __forceinline__ unsigned xb_xcc_id() { return (unsigned)__builtin_amdgcn_s_getreg((3 << 11) | 20) & 0xFu; }
#define XB_SPIN(cond, bar) do { unsigned _sp = 0; while (cond) { __builtin_amdgcn_s_sleep(1); \
    if ((++_sp & 255u) == 0u) { if (xb_ld(&(bar)[XB_TMO])) break; if (_sp > XB_SPIN_CAP) { atomicAdd(&(bar)[XB_TMO], 1u); break; } } } } while (0)

struct XcdBarrier {
    unsigned* bar; unsigned x;
    volatile LAS unsigned* st;
};

__device__ __forceinline__ XcdBarrier xcd_barrier_post(unsigned* bar, volatile LAS unsigned* st) {
    XcdBarrier b; b.bar = bar; b.x = xb_xcc_id(); b.st = st;
    if (threadIdx.x == 0) (void)xb_add(&bar[XB_XCNT(b.x)], 1u);
    return b;
}
__device__ __forceinline__ void xcd_barrier_complete(unsigned* bar, unsigned x, unsigned& nloc, unsigned& nx) {
    const unsigned G = gridDim.x * gridDim.y * gridDim.z;
    unsigned sum, cnt, mine, sp = 0u;
    for (;;) {
        sum = 0u; cnt = 0u; mine = 0u;
#pragma unroll
        for (unsigned j = 0; j < 16; ++j) { const unsigned c = xb_ld(&bar[XB_XCNT(j)]); sum += c; cnt += (c > 0u) ? 1u : 0u; mine = (j == x) ? c : mine; }
        if (sum == G) break;
        __builtin_amdgcn_s_sleep(1);
        if ((++sp & 255u) == 0u) { if (xb_ld(&bar[XB_TMO])) break; if (sp > XB_SPIN_CAP) { atomicAdd(&bar[XB_TMO], 1u); break; } }
    }
    nloc = mine > 0u ? mine : 1u; nx = cnt > 0u ? cnt : 1u;
}

__device__ __forceinline__ void xcd_barrier(const XcdBarrier& b) {
    asm volatile("s_waitcnt vmcnt(0)" ::: "memory");
    __syncthreads();
    if (threadIdx.x == 0) {
        unsigned* bar = b.bar;
        __builtin_amdgcn_s_waitcnt(0);
        unsigned nloc = b.st[0], nx = b.st[1];
        if (nloc == 0u) { xcd_barrier_complete(bar, b.x, nloc, nx); b.st[0] = nloc; b.st[1] = nx; }
        const unsigned old = xb_add(&bar[XB_XSUB(b.x)], 1u);
        const unsigned gen = old / nloc;
        if (old + 1u == (gen + 1u) * nloc) {
            __builtin_amdgcn_fence(__ATOMIC_RELEASE, "agent");
            asm volatile("s_waitcnt vmcnt(0)" ::: "memory");
            const unsigned og = xb_add(&bar[XB_TOP], 1u);
            const unsigned tg = og / nx;
            if (og + 1u == (tg + 1u) * nx) xb_add(&bar[XB_TOPGEN], 1u);
            else XB_SPIN(xb_ld(&bar[XB_TOPGEN]) == tg, bar);
            __builtin_amdgcn_fence(__ATOMIC_ACQUIRE, "agent");
            xb_add(&bar[XB_XGEN(b.x)], 1u);
            asm volatile("s_waitcnt vmcnt(0)" ::: "memory");
        } else {
            XB_SPIN(xb_ld(&bar[XB_XGEN(b.x)]) == gen, bar);
            __builtin_amdgcn_fence(__ATOMIC_ACQUIRE, "agent");
            asm volatile("s_waitcnt vmcnt(0)" ::: "memory");
        }
    }
    __syncthreads();
}


constexpr int RING_BYTES = 131072;
constexpr int LDS_BYTES = 147456;
constexpr int LDS_MISC = 146432;
constexpr int NWAVES = 8;
constexpr int NPHASE = 9;

struct Frame {
    LAS unsigned char* lds; int tid, lane, wave, vcu, G;
};

__device__ __forceinline__ unsigned f2bf(float f) { unsigned u = __builtin_bit_cast(unsigned, f); return (u + 0x7fffu + ((u >> 16) & 1u)) >> 16; }
__device__ __forceinline__ unsigned pk2(float lo, float hi) { return f2bf(lo) | (f2bf(hi) << 16); }

__device__ __forceinline__ void gemv9_item(const LAS float* Sl, LAS float* red, const float* W, int ldw, int col0, float* out, int ldo, const float* bias, int tid) {
    const int col = tid & 63, kq = tid >> 6;
    float a0 = 0.f, a1 = 0.f, a2 = 0.f, a3 = 0.f, a4 = 0.f, a5 = 0.f, a6 = 0.f, a7 = 0.f, a8 = 0.f;
    const float* wp = W + (size_t)(kq * 128) * ldw + col0 + col;
    for (int kb = 0; kb < 128; kb += 16) {
        float w[16];
#pragma unroll
        for (int kk = 0; kk < 16; ++kk) w[kk] = wp[(size_t)(kb + kk) * ldw];
#pragma unroll
        for (int kk = 0; kk < 16; ++kk) {
            const LAS f32x4* sp = (const LAS f32x4*)(Sl + (kq * 128 + kb + kk) * 12);
            const f32x4 s0 = sp[0], s1 = sp[1], s2 = sp[2]; const float wv = w[kk];
            a0 += s0[0] * wv; a1 += s0[1] * wv; a2 += s0[2] * wv; a3 += s0[3] * wv; a4 += s1[0] * wv; a5 += s1[1] * wv; a6 += s1[2] * wv; a7 += s1[3] * wv; a8 += s2[0] * wv;
        }
    }
    LAS float* rp = red + (kq * 9) * 64 + col;
    rp[0] = a0; rp[64] = a1; rp[128] = a2; rp[192] = a3; rp[256] = a4; rp[320] = a5; rp[384] = a6; rp[448] = a7; rp[512] = a8;
    __syncthreads();
    for (int i = tid; i < 576; i += 512) { const int r = i >> 6, c = i & 63; float s = 0.f;
#pragma unroll
        for (int q = 0; q < 8; ++q) s += red[(q * 9 + r) * 64 + c];
        out[(size_t)r * ldo + col0 + c] = s + (bias ? bias[col0 + c] : 0.f); }
    __syncthreads();
}

__device__ __forceinline__ void transpose_item(const float* W, int K, int N, bf16_t* WT, LAS float* scr, int item, int lane, bool permw) {
    const int nblk = N / 32, kb = item / nblk, nb = item % nblk, k0 = 64 * kb, n0 = 32 * nb;
    int d0 = n0;
    if (permw) { const int T = n0 >> 8, w = (n0 >> 6) & 3, bj = (n0 >> 5) & 1; d0 = 256 * T + 128 * bj + 32 * w; }
    f32x4 v[8];
#pragma unroll
    for (int i = 0; i < 8; ++i) v[i] = *(const f32x4*)(W + (size_t)(k0 + 8 * i + (lane >> 3)) * N + n0 + 4 * (lane & 7));
#pragma unroll
    for (int i = 0; i < 8; ++i) { LAS float* d = scr + (8 * i + (lane >> 3)) * 33 + 4 * (lane & 7); d[0] = v[i][0]; d[1] = v[i][1]; d[2] = v[i][2]; d[3] = v[i][3]; }
    asm volatile("s_waitcnt lgkmcnt(0)" ::: "memory");
    const int c = lane & 7;
#pragma unroll
    for (int j = 0; j < 4; ++j) { const int n = (lane >> 3) + 8 * j; const LAS float* sp = scr + (8 * c) * 33 + n;
        u32x4 o; o.x = pk2(sp[0 * 33], sp[1 * 33]); o.y = pk2(sp[2 * 33], sp[3 * 33]); o.z = pk2(sp[4 * 33], sp[5 * 33]); o.w = pk2(sp[6 * 33], sp[7 * 33]);
        *(u32x4*)(WT + (size_t)(d0 + n) * K + k0 + 8 * c) = o; }
    asm volatile("s_waitcnt lgkmcnt(0)" ::: "memory");
}

#if DEBUG_ATTN
constexpr size_t WS_DBG = 3584 * 1024;
__device__ __forceinline__ void dbg_load64(const bf16_t* p, float (&x)[64]) {
#pragma unroll
    for (int c = 0; c < 8; ++c) { const u32x4 w = *(const u32x4*)(p + 8 * c);
        x[8 * c + 0] = bf_lo(w.x); x[8 * c + 1] = bf_hi(w.x); x[8 * c + 2] = bf_lo(w.y); x[8 * c + 3] = bf_hi(w.y); x[8 * c + 4] = bf_lo(w.z); x[8 * c + 5] = bf_hi(w.z); x[8 * c + 6] = bf_lo(w.w); x[8 * c + 7] = bf_hi(w.w); }
}
__device__ __forceinline__ float dbg_dot(const bf16_t* p, const float (&q)[64]) {
    float s = 0.f;
#pragma unroll
    for (int c = 0; c < 8; ++c) { const u32x4 w = *(const u32x4*)(p + 8 * c);
        s += q[8 * c + 0] * bf_lo(w.x) + q[8 * c + 1] * bf_hi(w.x) + q[8 * c + 2] * bf_lo(w.y) + q[8 * c + 3] * bf_hi(w.y) + q[8 * c + 4] * bf_lo(w.z) + q[8 * c + 5] * bf_hi(w.z) + q[8 * c + 6] * bf_lo(w.w) + q[8 * c + 7] * bf_hi(w.w); }
    return s;
}
__device__ __forceinline__ void dbg_task(int row, int h, int mix, const bf16_t* Qs, const bf16_t* Ofast, const bf16_t* Kb, const bf16_t* Vb, int kp, const float* nat_bias, float* acc, int lane) {
    const bool prompt = row < MP;
    const int b = prompt ? row / SEQP : (row - MP) / SEQS, t = prompt ? row % SEQP : (row - MP) % SEQS;
    const int hk = mix ? h : (h >> 2);
    float q[64]; dbg_load64(Qs + (size_t)row * 512 + h * 64, q);
    const size_t kvbase = prompt ? (size_t)NBS * KVL + (size_t)b * SEQP : (size_t)b * KVL;
    const int gr = t >> 6, gc = t & 63; int rs = gr - 4; rs = rs < 0 ? 0 : (rs > 56 ? 56 : rs); int cs = gc - 8; cs = cs < 0 ? 0 : (cs > 48 ? 48 : cs);
    const int nk = prompt ? SEQP : (mix ? PAST + 128 : KVL);
    float mx = -INFINITY;
    for (int i = lane; i < nk; i += 64) {
        int kr = i; float bias = 0.f;
        if (!prompt && mix && i >= PAST) { const int w = i - PAST, wr_ = w >> 4, wc_ = w & 15, krow = rs + wr_, kcol = cs + wc_; kr = PAST + krow * 64 + kcol;
            bias = nat_bias[(h * 15 + (krow - gr + 7)) * 31 + (kcol - gc + 15)] * LOG2E; }
        const float sc = dbg_dot(Kb + (kvbase + kr) * kp + hk * 64, q) + bias;
        mx = fmaxf(mx, sc);
    }
#pragma unroll
    for (int o = 1; o < 64; o <<= 1) mx = fmaxf(mx, __shfl_xor(mx, o));
    float l = 0.f; float ov[64];
#pragma unroll
    for (int d = 0; d < 64; ++d) ov[d] = 0.f;
    for (int i = lane; i < nk; i += 64) {
        int kr = i; float bias = 0.f;
        if (!prompt && mix && i >= PAST) { const int w = i - PAST, wr_ = w >> 4, wc_ = w & 15, krow = rs + wr_, kcol = cs + wc_; kr = PAST + krow * 64 + kcol;
            bias = nat_bias[(h * 15 + (krow - gr + 7)) * 31 + (kcol - gc + 15)] * LOG2E; }
        const float sc = dbg_dot(Kb + (kvbase + kr) * kp + hk * 64, q) + bias;
        const float pe = exp2f(sc - mx); l += pe;
        const bf16_t* vp = Vb + (kvbase + kr) * kp + hk * 64;
#pragma unroll
        for (int c = 0; c < 8; ++c) { const u32x4 w = *(const u32x4*)(vp + 8 * c);
            ov[8 * c + 0] += pe * bf_lo(w.x); ov[8 * c + 1] += pe * bf_hi(w.x); ov[8 * c + 2] += pe * bf_lo(w.y); ov[8 * c + 3] += pe * bf_hi(w.y); ov[8 * c + 4] += pe * bf_lo(w.z); ov[8 * c + 5] += pe * bf_hi(w.z); ov[8 * c + 6] += pe * bf_lo(w.w); ov[8 * c + 7] += pe * bf_hi(w.w); }
    }
    l = wave_sum(l); float mine = 0.f;
#pragma unroll
    for (int d = 0; d < 64; ++d) { const float tot = wave_sum(ov[d]); if (lane == d) mine = tot; }
    const float ref = mine / l;
    const bf16_t fo = Ofast[(size_t)row * 512 + h * 64 + lane]; const float fast = __uint_as_float((unsigned)fo << 16);
    const float df = fast - ref; const float sd = wave_sum(df * df), sr = wave_sum(ref * ref);
    const int cat = (prompt ? 0 : 2) + mix;
    if (lane == 0) { atomicAdd(acc + 2 * cat, sd); atomicAdd(acc + 2 * cat + 1, sr); }
}
#endif

#if DEBUG_ATTN
__device__ __forceinline__ void dbg_rope_task(int row, int h, int which, const float* xs, const float* mod, const float* n1g, const float* w_in, const float* qg, const float* kg,
                                              const bf16_t* Qs, const bf16_t* KAb, float* acc, LAS float* hs, int lane) {
    const int b = (row - MP) / SEQS, t = (row - MP) % SEQS;
    const float* xrow = xs + (size_t)(row - MP) * DM; const float* modr = mod + (size_t)b * NMOD;
    float xv[16]; float ss = 0.f;
#pragma unroll
    for (int j = 0; j < 16; ++j) { xv[j] = xrow[lane + 64 * j]; ss += xv[j] * xv[j]; }
    const float inv = 1.0f / sqrtf(wave_sum(ss) * (1.0f / DM) + RMS_EPS);
#pragma unroll
    for (int j = 0; j < 16; ++j) { const int c = lane + 64 * j; hs[c] = (xv[j] * inv) * n1g[c] * (1.0f + modr[1024 + c]) + modr[c]; }
    asm volatile("s_waitcnt lgkmcnt(0)" ::: "memory");
    const int col = (which ? 512 + h * 64 : h * 64) + lane;
    float val = 0.f;
    for (int k = 0; k < DM; ++k) val += hs[k] * w_in[(size_t)k * NIN + col];
    const float s2 = wave_sum(val * val);
    float v = val * (1.0f / sqrtf(s2 * (1.0f / 64.0f) + RMS_EPS)) * (which ? kg[lane] : qg[lane]);
    const int gr = t >> 6, gc = t & 63, i = lane & 15, pos = (lane & 32) ? gc : gr;
    const float invf = powf(10000.0f, -(float)i / 16.0f), ang = (float)pos * invf, co = cosf(ang), sn = sinf(ang);
    const float oth = __shfl_xor(v, 16);
    float o = (lane & 16) ? (oth * sn + v * co) : (v * co - oth * sn);
    if (!which) o *= C2;
    const bf16_t fb = which ? KAb[((size_t)b * KVL + PAST + t) * 128 + h * 64 + lane] : Qs[(size_t)row * 512 + h * 64 + lane];
    const float fast = __uint_as_float((unsigned)fb << 16), df = fast - o;
    const float sd = wave_sum(df * df), sr = wave_sum(o * o);
    if (lane == 0) { atomicAdd(acc + 2 * (4 + which), sd); atomicAdd(acc + 2 * (4 + which) + 1, sr); }
}
#endif

struct Args { const float* in[22]; float* out; unsigned char* ws; int ph_lo, ph_hi; };

__global__ void __launch_bounds__(NWAVES * 64, 2) fwd_kernel(Args args) {
    extern __shared__ __attribute__((aligned(16))) unsigned char lds[];
    Frame F;
    F.lds = (LAS unsigned char*)lds;
    F.tid = 0; F.lane = 0; F.wave = __builtin_amdgcn_readfirstlane(threadIdx.x >> 6);
    F.G = gridDim.x; { const int bx = blockIdx.x; F.vcu = (F.G % 8 == 0) ? (bx % 8) * (F.G / 8) + bx / 8 : bx; }
    XcdBarrier bar;
    {   volatile LAS unsigned* misc = (volatile LAS unsigned*)(F.lds + LDS_MISC);
        if (threadIdx.x < 2) misc[threadIdx.x] = 0u;
        __syncthreads();
        unsigned char* ws0 = args.ws;
        bar = xcd_barrier_post((unsigned*)(ws0 + WS_BAR), misc);
    }
#define KARG(T, idx) ({ unsigned o_ = (unsigned)(idx) * 8u; asm volatile("" : "+s"(o_)); (T)(*(const unsigned long long __attribute__((address_space(4)))*)((const char __attribute__((address_space(4)))*)__builtin_amdgcn_kernarg_segment_ptr() + o_)); })
#define IN_X_PROMPT 0
#define IN_X_SAMPLE 1
#define IN_CACHE_AK 2
#define IN_CACHE_AV 3
#define IN_CACHE_BK 4
#define IN_CACHE_BV 5
#define IN_C 6
#define IN_C_CTX 7
#define IN_W_MOD 8
#define IN_B_MOD 9
#define IN_N1G 10
#define IN_N2G 11
#define IN_W_IN 12
#define IN_QNG 13
#define IN_KNG 14
#define IN_NAT_BIAS 15
#define IN_W_BRA 16
#define IN_W_BRB 17
#define IN_W_OUT 18
#define IN_W_1 19
#define IN_W_2 20
#define IN_FNG 21
#define ARG_OUT 22
#define ARG_WS 23
#define WSP(T, off) ((T)(ws + (off)))
    unsigned long long pr_t0 = 0ull, pr_dt = 0ull;
#define PROBE_START(k) do { if (PROBE_LO == (k)) pr_t0 = __builtin_amdgcn_s_memrealtime(); } while (0)
#define PROBE_STOP(k) do { if (PROBE_HI == (k)) pr_dt = __builtin_amdgcn_s_memrealtime() - pr_t0; } while (0)
#define FRESH_TID() do { int t_ = threadIdx.x; asm volatile("" : "+v"(t_)); F.tid = t_; F.lane = t_ & 63; } while (0)
#if MK_PER_PHASE
    const int lo = args.ph_lo, hi = args.ph_hi;
#else
    constexpr int lo = 0, hi = NPHASE;
#endif
#define IN(k) (lo <= (k) && (k) < hi)
#define GRID_SYNC() do { asm volatile("s_waitcnt vmcnt(0) lgkmcnt(0)" ::: "memory"); xcd_barrier(bar); } while (0)
#define SEAM(k) do { if (IN(k) && IN((k) + 1)) GRID_SYNC(); } while (0)

    PROBE_START(0);
    if (IN(0)) {
        FRESH_TID();
        unsigned char* ws = KARG(unsigned char*, ARG_WS);
        const float* cvec = KARG(const float*, IN_C); const float* c_ctx = KARG(const float*, IN_C_CTX); const float* w_mod = KARG(const float*, IN_W_MOD); const float* b_mod = KARG(const float*, IN_B_MOD);
        const float* cache_ak = KARG(const float*, IN_CACHE_AK); const float* cache_av = KARG(const float*, IN_CACHE_AV); const float* cache_bk = KARG(const float*, IN_CACHE_BK); const float* cache_bv = KARG(const float*, IN_CACHE_BV);
        float* MOD = WSP(float*, WS_MOD); float* ROPEC = WSP(float*, WS_ROPE); float* ROPES = ROPEC + 1024;
        bf16_t* KA = WSP(bf16_t*, WS_KA); bf16_t* VA = WSP(bf16_t*, WS_VA); bf16_t* KB = WSP(bf16_t*, WS_KB); bf16_t* VB = WSP(bf16_t*, WS_VB);
#if DEBUG_ATTN
        if (blockIdx.x == 0 && F.tid < 16) WSP(float*, WS_DBG)[F.tid] = 0.f;
#endif
        LAS float* Sl = (LAS float*)F.lds; LAS float* red = (LAS float*)(F.lds + 49152);
        if ((int)blockIdx.x < 96) {
            for (int i = F.tid; i < 9 * 1024; i += 512) { const int r = i >> 10, k = i & 1023; const float v = (r < 8) ? cvec[r * 1024 + k] : c_ctx[k]; Sl[k * 12 + r] = v / (1.0f + expf(-v)); }
            __syncthreads();
            for (int it = blockIdx.x; it < 96; it += F.G) gemv9_item(Sl, red, w_mod, NMOD, it * 64, MOD, NMOD, b_mod, F.tid);
        }
        if ((int)blockIdx.x == F.G - 1) {
            for (int i = F.tid; i < 1024; i += 512) { const int pos = i >> 4, pi = i & 15;
                const float b4 = (pi & 3) == 0 ? 1.0f : ((pi & 3) == 1 ? 0.5623413251903491f : ((pi & 3) == 2 ? 0.31622776601683794f : 0.1778279410038923f));
                const float d4 = (pi >> 2) == 0 ? 1.0f : ((pi >> 2) == 1 ? 0.1f : ((pi >> 2) == 2 ? 0.01f : 0.001f));
                const float ang = (float)pos * (b4 * d4);
                const float kq = rintf(ang * 0.15915494309189535f);
                float r = fmaf(-kq, 6.2831854820251465f, ang); r = fmaf(-kq, -1.7484555e-7f, r);
                ROPEC[i] = cosf(r); ROPES[i] = sinf(r); }
        }
        { const int gt = F.vcu * 512 + F.tid, NT_ = F.G * 512;
          for (int e = gt; e < 2 * 131072; e += NT_) {
              const int which = e >= 131072; const int q = which ? e - 131072 : e; const int b = q >> 14, p = (q >> 5) & 511, c4 = q & 31;
              const f32x4 v = *(const f32x4*)((which ? cache_av : cache_ak) + (size_t)q * 4);
              u32x2 w; w.x = pk2(v[0], v[1]); w.y = pk2(v[2], v[3]);
              *(u32x2*)((which ? VA : KA) + ((size_t)(b * KVL + p)) * 128 + c4 * 4) = w; }
          for (int e = gt; e < 2 * 524288; e += NT_) {
              const int which = e >= 524288; const int q = which ? e - 524288 : e; const int b = q >> 16, p = (q >> 7) & 511, c4 = q & 127;
              const f32x4 v = *(const f32x4*)((which ? cache_bv : cache_bk) + (size_t)q * 4);
              u32x2 w; w.x = pk2(v[0], v[1]); w.y = pk2(v[2], v[3]);
              *(u32x2*)((which ? VB : KB) + ((size_t)(b * KVL + p)) * 512 + c4 * 4) = w; } }
    }
    SEAM(0);
    PROBE_STOP(0);

    PROBE_START(1);
    if (IN(1)) {
        FRESH_TID();
        unsigned char* ws = KARG(unsigned char*, ARG_WS);
        const float* x_prompt = KARG(const float*, IN_X_PROMPT); const float* x_sample = KARG(const float*, IN_X_SAMPLE); const float* n1g = KARG(const float*, IN_N1G);
        const float* w_in = KARG(const float*, IN_W_IN); const float* w_bra = KARG(const float*, IN_W_BRA); const float* w_brb = KARG(const float*, IN_W_BRB); const float* w_out = KARG(const float*, IN_W_OUT);
        const float* w_1 = KARG(const float*, IN_W_1); const float* w_2 = KARG(const float*, IN_W_2);
        float* MOD = WSP(float*, WS_MOD); float* BUP = WSP(float*, WS_BUP); bf16_t* Hb = WSP(bf16_t*, WS_H);
        bf16_t* WIN_t = WSP(bf16_t*, WS_WIN); bf16_t* WBRA_t = WSP(bf16_t*, WS_WBRA); bf16_t* WBRB_t = WSP(bf16_t*, WS_WBRB); bf16_t* WOUT_t = WSP(bf16_t*, WS_WOUT); bf16_t* W1_t = WSP(bf16_t*, WS_W1); bf16_t* W2_t = WSP(bf16_t*, WS_W2);
        if ((int)blockIdx.x < 64) {
            LAS float* Sl = (LAS float*)F.lds; LAS float* red = (LAS float*)(F.lds + 49152);
            for (int i = F.tid; i < 9 * 1024; i += 512) { const int r = i >> 10, k = i & 1023; Sl[k * 12 + r] = MOD[(size_t)r * NMOD + 3072 + k]; }
            __syncthreads();
            for (int it = blockIdx.x; it < 64; it += F.G) gemv9_item(Sl, red, w_1, FF, it * 64, BUP, FF, nullptr, F.tid);
        }
        LAS float* scr = (LAS float*)(F.lds + F.wave * 16384);
        const int gw = F.vcu * NWAVES + F.wave, NGW = F.G * NWAVES;
        constexpr int I_IN = (DM / 64) * (NIN / 32), I_BR = (512 / 64) * (DM / 32), I_O = (DM / 64) * (DM / 32), I_1 = (DM / 64) * (FF / 32), I_2 = (FF / 64) * (DM / 32);
        constexpr int NITEMS = I_IN + 2 * I_BR + I_O + I_1 + I_2;
        for (int it = gw; it < NITEMS; it += NGW) {
            int r = it;
            if (r < I_IN) { transpose_item(w_in, DM, NIN, WIN_t, scr, r, F.lane, true); continue; } r -= I_IN;
            if (r < I_BR) { transpose_item(w_bra, 512, DM, WBRA_t, scr, r, F.lane, false); continue; } r -= I_BR;
            if (r < I_BR) { transpose_item(w_brb, 512, DM, WBRB_t, scr, r, F.lane, false); continue; } r -= I_BR;
            if (r < I_O) { transpose_item(w_out, DM, DM, WOUT_t, scr, r, F.lane, false); continue; } r -= I_O;
            if (r < I_1) { transpose_item(w_1, DM, FF, W1_t, scr, r, F.lane, false); continue; } r -= I_1;
            transpose_item(w_2, FF, DM, W2_t, scr, r, F.lane, false);
        }
        for (int m0 = gw * 4; m0 < M; m0 += NGW * 4) {
            const float* xrow0 = (m0 < MP) ? x_prompt + (size_t)m0 * DM : x_sample + (size_t)(m0 - MP) * DM;
            const int mrow = (m0 < MP) ? 8 : ((m0 - MP) >> 12);
            const float* modr = MOD + (size_t)mrow * NMOD;
            f32x4 v[4][4]; float s[4];
#pragma unroll
            for (int r = 0; r < 4; ++r)
#pragma unroll
                for (int j = 0; j < 4; ++j) v[r][j] = ((const f32x4*)(xrow0 + (size_t)r * DM))[F.lane + 64 * j];
#pragma unroll
            for (int r = 0; r < 4; ++r) { s[r] = 0.f;
#pragma unroll
                for (int j = 0; j < 4; ++j) s[r] += (v[r][j][0] * v[r][j][0] + v[r][j][1] * v[r][j][1]) + (v[r][j][2] * v[r][j][2] + v[r][j][3] * v[r][j][3]); }
#pragma unroll
            for (int o = 1; o < 64; o <<= 1) {
#pragma unroll
                for (int r = 0; r < 4; ++r) s[r] += __shfl_xor(s[r], o); }
#pragma unroll
            for (int j = 0; j < 4; ++j) { const int c = 4 * F.lane + 256 * j;
                const f32x4 g = *(const f32x4*)(n1g + c), sc = *(const f32x4*)(modr + 1024 + c), sh = *(const f32x4*)(modr + c);
                const f32x4 gs = g * (sc + 1.0f);
#pragma unroll
                for (int r = 0; r < 4; ++r) { const float inv = 1.0f / sqrtf(s[r] * (1.0f / DM) + RMS_EPS);
                    const f32x4 h = ((v[r][j] * inv) * g) * (sc + 1.0f) + sh;
                    ((unsigned long long*)(Hb + (size_t)(m0 + r) * DM))[F.lane + 64 * j] = (unsigned long long)pk2(h[0], h[1]) | ((unsigned long long)pk2(h[2], h[3]) << 32); }
                (void)gs; }
        }
    }
    SEAM(1);
    PROBE_STOP(1);

    PROBE_START(2);
    if (IN(2)) {
        unsigned char* ws = KARG(unsigned char*, ARG_WS); float* out = KARG(float*, ARG_OUT); const float* qng = KARG(const float*, IN_QNG); const float* kng = KARG(const float*, IN_KNG);
        OpsPlain P{(const char*)(ws + WS_H), (const char*)(ws + WS_WIN), (size_t)256 * DM * 2};
        pg8::StaticOrder S; S.init(M, NIN, F.G, (int)blockIdx.x);
        EpiIn E{ws, out, qng, kng};
        pg8::gemm_phase<EpiIn, pg8::StaticOrder, OpsPlain>(F.lds, P, DM, S, E);
    }
    SEAM(2);
    PROBE_STOP(2);

    PROBE_START(3);
    if (IN(3)) {
        using namespace attn_body;
        FRESH_TID();
        unsigned char* ws = KARG(unsigned char*, ARG_WS); const float* nat_bias = KARG(const float*, IN_NAT_BIAS);
        bf16_t* QA = WSP(bf16_t*, WS_QA); bf16_t* QB = WSP(bf16_t*, WS_QB); bf16_t* KA = WSP(bf16_t*, WS_KA); bf16_t* VA = WSP(bf16_t*, WS_VA); bf16_t* KB = WSP(bf16_t*, WS_KB); bf16_t* VB = WSP(bf16_t*, WS_VB);
        char* shm = (char*)lds;
#if DEBUG_ATTN
        {
            const u32x4* src = (const u32x4*)QA; u32x4* dstq = (u32x4*)(ws + WS_H); const size_t n16 = (size_t)M * 512 * 2 * 2 / 16;
            for (size_t e = (size_t)F.vcu * 512 + F.tid; e < n16; e += (size_t)F.G * 512) dstq[e] = src[e];
            GRID_SYNC();
        }
#endif
        const int x = F.vcu >> 5, j = F.vcu & 31;
        if (F.G == 256) {
            { LAS float* mw = (LAS float*)(F.lds + LDS_MASK);
              for (int e = F.tid; e < 65 * MSKR; e += 512) { const int qc_ = e / MSKR, kc_ = e - qc_ * MSKR; int cs = qc_ - 8; cs = cs < 0 ? 0 : (cs > 48 ? 48 : cs); mw[e] = (qc_ < 64 && kc_ >= cs && kc_ < cs + 16) ? 0.f : -INFINITY; } }
            for (int i = 0; i < 4; ++i) {
                const int uu = i * 32 + j, grp = 2 * x + (uu >> 6), b = grp >> 1, kvh = grp & 1, h = kvh * 4 + ((uu & 63) >> 4), qb = uu & 15;
                const size_t row0 = (size_t)MP + (size_t)b * SEQS + (size_t)qb * 256;
                AttnDesc d; d.Qw0 = (const bf16*)QA + row0 * 512 + h * 64; d.Ow0 = (bf16*)QA + row0 * 512 + h * 64;
                d.Kh = (const bf16*)KA + (size_t)b * KVL * 128 + kvh * 64; d.Vh = (const bf16*)VA + (size_t)b * KVL * 128 + kvh * 64;
                d.qp = 512; d.kp = 128; d.NT = KVL / 64; d.lo = 0; d.qrow0 = 0;
                attn_unit<0, 8>(d, shm);
            }
            for (int i = 0; i < 4; ++i) {
                const int uu = i * 32 + j, pr = 8 * x + (uu >> 4), b = pr >> 3, h = pr & 7, qb = uu & 15;
                const size_t row0 = (size_t)MP + (size_t)b * SEQS + (size_t)qb * 256;
                { LAS float* tabw = (LAS float*)(F.lds + LDS_TAB);
                  for (int e = F.tid; e < 4 * 16 * 132; e += 512) { const int sc = e / 2112, rem = e - sc * 2112, dr = rem / 132, jj = rem - dr * 132, df = jj - sc - 64;
                      tabw[sc * (TABC + 1) - sc + dr * TABR + jj] = (dr < 15 && df >= -15 && df <= 15) ? nat_bias[(h * 15 + dr) * 31 + df + 15] * LOG2E : 0.f; }
                  asm volatile("s_waitcnt vmcnt(0) lgkmcnt(0)\n\ts_barrier" ::: "memory"); }
                int lo_ = 4 * qb - 4; lo_ = lo_ < 0 ? 0 : lo_; int nloc = (qb == 0 || qb == 15) ? 8 : 12; if (qb == 15) lo_ = 56; if (lo_ > 64 - nloc) lo_ = 64 - nloc;
                AttnDesc d; d.Qw0 = (const bf16*)QB + row0 * 512 + h * 64; d.Ow0 = (bf16*)QB + row0 * 512 + h * 64;
                d.Kh = (const bf16*)KB + (size_t)b * KVL * 512 + h * 64; d.Vh = (const bf16*)VB + (size_t)b * KVL * 512 + h * 64;
                d.qp = 512; d.kp = 512; d.NT = 8 + nloc; d.lo = lo_; d.qrow0 = 4 * qb;
                attn_unit<1, 8>(d, shm);
            }
            for (int i = 0; i < 2; ++i) {
                const int uu = i * 32 + j, b = 4 * x + (uu >> 4), hh = uu & 15;
                const size_t row0 = (size_t)b * SEQP, kv0 = (size_t)NBS * KVL + (size_t)b * SEQP;
                AttnDesc d; d.NT = 4; d.lo = 0; d.qrow0 = 0; d.qp = 512;
                if (hh < 8) { d.Qw0 = (const bf16*)QA + row0 * 512 + hh * 64; d.Ow0 = (bf16*)QA + row0 * 512 + hh * 64;
                    d.Kh = (const bf16*)KA + kv0 * 128 + (hh >> 2) * 64; d.Vh = (const bf16*)VA + kv0 * 128 + (hh >> 2) * 64; d.kp = 128; }
                else { const int h = hh - 8; d.Qw0 = (const bf16*)QB + row0 * 512 + h * 64; d.Ow0 = (bf16*)QB + row0 * 512 + h * 64;
                    d.Kh = (const bf16*)KB + kv0 * 512 + h * 64; d.Vh = (const bf16*)VB + kv0 * 512 + h * 64; d.kp = 512; }
                attn_unit<0, 8>(d, shm);
            }
        }
    }
    SEAM(3);
    PROBE_STOP(3);
#if DEBUG_ATTN
    {
        FRESH_TID();
        unsigned char* ws = KARG(unsigned char*, ARG_WS); const float* nat_bias = KARG(const float*, IN_NAT_BIAS);
        const bf16_t* QAs = WSP(const bf16_t*, WS_H); const bf16_t* QBs = WSP(const bf16_t*, WS_H + 40 * MiB);
        const int gw = F.vcu * NWAVES + F.wave;
        for (int jt = 0; jt < 8; ++jt) {
            const unsigned hsh = (unsigned)(gw * 8 + jt) * 2654435761u;
            const int mix = jt & 1, prm = (jt >> 1) & 1, h = (hsh >> 8) & 7;
            int row;
            if (prm) row = (int)((hsh >> 12) % MP);
            else { const int b = (hsh >> 11) & 7; int t;
                if (jt & 4) { const int er = (hsh >> 14) & 7, ec = (hsh >> 17) % 11;
                    const int rr = er == 0 ? 0 : er == 1 ? 1 : er == 2 ? 3 : er == 3 ? 4 : er == 4 ? 5 : er == 5 ? 59 : er == 6 ? 60 : 63;
                    const int cc = ec == 0 ? 0 : ec == 1 ? 1 : ec == 2 ? 7 : ec == 3 ? 8 : ec == 4 ? 9 : ec == 5 ? 31 : ec == 6 ? 32 : ec == 7 ? 55 : ec == 8 ? 56 : ec == 9 ? 57 : 63;
                    t = rr * 64 + cc; }
                else t = (hsh >> 14) % SEQS;
                row = MP + b * SEQS + t; }
            if (mix == 0) dbg_task(row, h, 0, QAs, WSP(const bf16_t*, WS_QA), WSP(const bf16_t*, WS_KA), WSP(const bf16_t*, WS_VA), 128, nat_bias, WSP(float*, WS_DBG), F.lane);
            else dbg_task(row, h, 1, QBs, WSP(const bf16_t*, WS_QB), WSP(const bf16_t*, WS_KB), WSP(const bf16_t*, WS_VB), 512, nat_bias, WSP(float*, WS_DBG), F.lane);
        }
        {   const float* xs_ = KARG(const float*, IN_X_SAMPLE); const float* n1g_ = KARG(const float*, IN_N1G); const float* w_in_ = KARG(const float*, IN_W_IN);
            const float* qg_ = KARG(const float*, IN_QNG); const float* kg_ = KARG(const float*, IN_KNG);
            LAS float* hs = (LAS float*)(F.lds + F.wave * 4096);
            for (int jt = 0; jt < 2; ++jt) {
                const unsigned hsh = (unsigned)(gw * 2 + jt + 77777) * 2654435761u;
                const int b = (hsh >> 11) & 7, t = (hsh >> 14) % SEQS, row = MP + b * SEQS + t;
                dbg_rope_task(row, jt ? ((hsh >> 8) & 1) : ((hsh >> 8) & 7), jt, xs_, WSP(const float*, WS_MOD), n1g_, w_in_, qg_, kg_, QAs, WSP(const bf16_t*, WS_KA), WSP(float*, WS_DBG), hs, F.lane);
            }
        }
        GRID_SYNC();
    }
#endif

    PROBE_START(4);
    if (IN(4)) {
        unsigned char* ws = KARG(unsigned char*, ARG_WS);
        OpsPair P{(const char*)(ws + WS_QA), (long)(WS_QB - WS_QA), (const char*)(ws + WS_WBRA), (long)(WS_WBRB - WS_WBRA), (size_t)256 * 512 * 2};
        pg8::PairOrder S; S.init(M, DM, F.G, (int)blockIdx.x);
        EpiBr E{WSP(const bf16_t*, WS_GA), WSP(const bf16_t*, WS_GB), WSP(bf16_t*, WS_MM)};
        pg8::gemm_phase<EpiBr, pg8::PairOrder, OpsPair>(F.lds, P, 512, S, E, STAG_P4);
    }
    SEAM(4);
    PROBE_STOP(4);

    PROBE_START(5);
    if (IN(5)) {
        unsigned char* ws = KARG(unsigned char*, ARG_WS); float* out = KARG(float*, ARG_OUT);
        const float* x_prompt = KARG(const float*, IN_X_PROMPT); const float* x_sample = KARG(const float*, IN_X_SAMPLE); const float* n2g = KARG(const float*, IN_N2G);
        OpsPlain P{(const char*)(ws + WS_MM), (const char*)(ws + WS_WOUT), (size_t)256 * DM * 2};
        pg8::StaticOrder S; S.init(M, DM, F.G, (int)blockIdx.x);
        EpiOut E{x_prompt, x_sample, WSP(const float*, WS_MOD), n2g, out + OUT_Y, WSP(bf16_t*, WS_XW), WSP(float*, WS_SSQ)};
        pg8::gemm_phase<EpiOut, pg8::StaticOrder, OpsPlain>(F.lds, P, DM, S, E, STAG_P5);
    }
    SEAM(5);
    PROBE_STOP(5);

    PROBE_START(6);
    if (IN(6)) {
        unsigned char* ws = KARG(unsigned char*, ARG_WS);
        OpsPlain P{(const char*)(ws + WS_XW), (const char*)(ws + WS_W1), (size_t)256 * DM * 2};
        pg8::StaticOrder S; S.init(M, FF, F.G, (int)blockIdx.x);
        EpiUp E{WSP(const float*, WS_SSQ), WSP(const float*, WS_BUP), WSP(bf16_t*, WS_HID)};
        pg8::gemm_phase<EpiUp, pg8::StaticOrder, OpsPlain>(F.lds, P, DM, S, E);
    }
    SEAM(6);
    PROBE_STOP(6);

    PROBE_START(7);
    if (IN(7)) {
        unsigned char* ws = KARG(unsigned char*, ARG_WS); float* out = KARG(float*, ARG_OUT);
        OpsPlain P{(const char*)(ws + WS_HID), (const char*)(ws + WS_W2), (size_t)256 * FF * 2};
        pg8::StaticOrder S; S.init(M, DM, F.G, (int)blockIdx.x);
        EpiDown E{WSP(const float*, WS_MOD), out + OUT_Y};
        pg8::gemm_phase<EpiDown, pg8::StaticOrder, OpsPlain>(F.lds, P, FF, S, E, STAG_P7);
    }
    SEAM(7);
    PROBE_STOP(7);

    PROBE_START(8);
    if (IN(8)) {
        FRESH_TID();
        float* out = KARG(float*, ARG_OUT); const float* fng = KARG(const float*, IN_FNG);
        const int gw = F.vcu * NWAVES + F.wave, NGW = F.G * NWAVES;
        for (int m0 = gw * 4; m0 < M; m0 += NGW * 4) {
            f32x4* xr = (f32x4*)(out + OUT_Y + (size_t)m0 * DM) + F.lane;
            f32x4 v[4][4]; float s[4];
#pragma unroll
            for (int r = 0; r < 4; ++r)
#pragma unroll
                for (int j = 0; j < 4; ++j) v[r][j] = xr[r * (DM / 4) + 64 * j];
#pragma unroll
            for (int r = 0; r < 4; ++r) { s[r] = 0.f;
#pragma unroll
                for (int j = 0; j < 4; ++j) s[r] += (v[r][j][0] * v[r][j][0] + v[r][j][1] * v[r][j][1]) + (v[r][j][2] * v[r][j][2] + v[r][j][3] * v[r][j][3]); }
#pragma unroll
            for (int o = 1; o < 64; o <<= 1) {
#pragma unroll
                for (int r = 0; r < 4; ++r) s[r] += __shfl_xor(s[r], o); }
#pragma unroll
            for (int j = 0; j < 4; ++j) { const f32x4 g = *(const f32x4*)(fng + 4 * F.lane + 256 * j);
#pragma unroll
                for (int r = 0; r < 4; ++r) { const float inv = 1.0f / sqrtf(s[r] * (1.0f / DM) + RMS_EPS); xr[r * (DM / 4) + 64 * j] = (v[r][j] * inv) * g; } }
        }
    }
    PROBE_STOP(8);
    if (PROBE_LO >= 0 && blockIdx.x == 0) { const unsigned long long te = __builtin_amdgcn_s_memrealtime(); while (__builtin_amdgcn_s_memrealtime() - te < PROBE_MULT * pr_dt) __builtin_amdgcn_s_sleep(16); }
#undef IN
#undef SEAM
}

extern "C" void kernel_launch(void* const* d_in, const int* in_sizes, int n_in, void* d_out, int out_size, void* d_ws, size_t ws_size, hipStream_t stream) {
    static int grid = 0;
    if (grid == 0) {
        if (n_in != 22 || ws_size < WS_END) { fprintf(stderr, "kernel_launch: unexpected problem (n_in %d, ws %zu)\n", n_in, ws_size); grid = -1; return; }
        int dev = 0, cus = 0, per_cu = 0;
        if (hipGetDevice(&dev) != hipSuccess || hipDeviceGetAttribute(&cus, hipDeviceAttributeMultiprocessorCount, dev) != hipSuccess) { grid = -1; return; }
        if (hipFuncSetAttribute((const void*)fwd_kernel, hipFuncAttributeMaxDynamicSharedMemorySize, LDS_BYTES) != hipSuccess) { fprintf(stderr, "kernel_launch: hipFuncSetAttribute failed\n"); grid = -1; return; }
        if (hipOccupancyMaxActiveBlocksPerMultiprocessor(&per_cu, (const void*)fwd_kernel, NWAVES * 64, LDS_BYTES) != hipSuccess || per_cu < 1) { fprintf(stderr, "kernel_launch: occupancy query says %d\n", per_cu); (void)hipGetLastError(); per_cu = 1; }
        grid = cus;
        if (grid != 256) fprintf(stderr, "kernel_launch: %d CUs; the attention phase is dealt for 256\n", grid);
    }
    if (grid < 0) return;
    Args a{};
    for (int i = 0; i < 22; ++i) a.in[i] = (const float*)d_in[i];
    a.out = (float*)d_out; a.ws = (unsigned char*)d_ws;
#if MK_PER_PHASE
    for (int p = 0; p < NPHASE; ++p) { a.ph_lo = p; a.ph_hi = p + 1; hipLaunchKernelGGL(fwd_kernel, dim3(grid), dim3(NWAVES * 64), LDS_BYTES, stream, a); }
#else
    a.ph_lo = 0; a.ph_hi = NPHASE;
    if (hipMemsetAsync((char*)d_ws + WS_BAR, 0, 16384, stream) != hipSuccess) { fprintf(stderr, "kernel_launch: memset of the barrier words failed\n"); return; }
    void* kargs[] = {&a};
    hipError_t e = hipLaunchCooperativeKernel((const void*)fwd_kernel, dim3(grid), dim3(NWAVES * 64), kargs, LDS_BYTES, stream);
    if (e != hipSuccess) fprintf(stderr, "kernel_launch: cooperative launch failed: %s\n", hipGetErrorString(e));
#endif
}
```

```cpp
#include <hip/hip_runtime.h>
#include <hip/hip_cooperative_groups.h>
#include <hip/hip_bf16.h>
#include <cstdio>
#include <cstdint>
#include <cmath>
namespace cg = cooperative_groups;

#ifndef MK_PER_PHASE
#define MK_PER_PHASE 0
#endif

#ifndef DEBUG_ATTN
#define DEBUG_ATTN 0
#endif
#ifndef PROBE_LO
#define PROBE_LO (-1)
#define PROBE_HI (-1)
#endif
#define PROBE_MULT 4
#ifndef STAG_P4
#define STAG_P4 0u
#define STAG_P5 0u
#define STAG_P7 0u
#endif
#ifndef DBG_THR
#define DBG_THR 2e-4f
#endif
#define LAS __attribute__((address_space(3)))
#define GAS __attribute__((address_space(1)))
typedef unsigned short bf16_t;
typedef short bf16x8 __attribute__((ext_vector_type(8)));
typedef float f32x4 __attribute__((ext_vector_type(4)));
typedef float f32x2 __attribute__((ext_vector_type(2)));
typedef unsigned u32x4 __attribute__((ext_vector_type(4)));
typedef unsigned u32x2 __attribute__((ext_vector_type(2)));

constexpr int DM = 1024, NBP = 32, SEQP = 256, NBS = 8, SEQS = 4096, PAST = 512;
constexpr int MP = NBP * SEQP, MS = NBS * SEQS, M = MP + MS;
constexpr int NIN = 4352, FF = 4096, NMOD = 6 * DM;
constexpr int KVL = PAST + SEQS;
constexpr int KVROWS = NBS * KVL + MP;
constexpr float RMS_EPS = 1e-6f;
constexpr float LOG2E = 1.4426950408889634f;
constexpr float C2 = 0.125f * LOG2E;
constexpr size_t OUT_Y = 0, OUT_AK = (size_t)M * DM, OUT_AV = OUT_AK + (size_t)MP * 128, OUT_BK = OUT_AV + (size_t)MP * 128, OUT_BV = OUT_BK + (size_t)MP * 512;
constexpr size_t MiB = 1u << 20;
constexpr size_t WS_MOD = 0, WS_BUP = 256 * 1024, WS_ROPE = 512 * 1024, WS_BAR = 768 * 1024  , WS_SSQ = 1 * MiB;
constexpr size_t WS_WIN = 4 * MiB, WS_WBRA = 13 * MiB, WS_WBRB = 14 * MiB, WS_WOUT = 15 * MiB, WS_W1 = 17 * MiB, WS_W2 = 25 * MiB;
constexpr size_t WS_H = 34 * MiB, WS_QA = 114 * MiB, WS_QB = 154 * MiB, WS_KA = 194 * MiB, WS_VA = 205 * MiB, WS_KB = 216 * MiB, WS_VB = 260 * MiB;
constexpr size_t WS_GA = 304 * MiB, WS_GB = 384 * MiB, WS_XW = 432 * MiB, WS_HID = 34 * MiB, WS_MM = 34 * MiB, WS_END = 512 * MiB;
static_assert(WS_WIN + (size_t)NIN * DM * 2 <= WS_WBRA && WS_W2 + (size_t)DM * FF * 2 <= WS_H && WS_KA + (size_t)KVROWS * 128 * 2 <= WS_VA && WS_KB + (size_t)KVROWS * 512 * 2 <= WS_VB, "ws map");
static_assert(WS_VB + (size_t)KVROWS * 512 * 2 <= WS_GA && WS_GB + (size_t)M * DM * 2 <= WS_END && WS_HID + (size_t)M * FF * 2 <= WS_XW && WS_XW + (size_t)M * DM * 2 <= WS_END, "ws map 2");
static_assert(WS_SSQ + (size_t)M * 16 * 4 <= WS_WIN, "ws map 3");

__device__ __forceinline__ unsigned cvt_pk_bf16(float lo, float hi) { unsigned r; asm volatile("v_cvt_pk_bf16_f32 %0, %1, %2" : "=v"(r) : "v"(lo), "v"(hi)); return r; }
__device__ __forceinline__ float bf_lo(unsigned w) { return __uint_as_float(w << 16); }
__device__ __forceinline__ float bf_hi(unsigned w) { return __uint_as_float(w & 0xffff0000u); }
__device__ __forceinline__ float wave_sum(float v) {
#pragma unroll
    for (int o = 1; o < 64; o <<= 1) v += __shfl_xor(v, o);
    return v;
}
__device__ __forceinline__ float sigmoidf_(float x) { return 1.0f / (1.0f + __expf(-x)); }

namespace pg8 {
constexpr int BM = 256, BK = 64, HALF = 128, HTB = HALF * BK * 2, STAGE_BYTES = 8 * HTB, NXCD = 8, WGM = 8;
__host__ __device__ __forceinline__ int lds_byte(int r, int c) { const int st = (r >> 4) * 2 + (c >> 5), rr = r & 15, cc = c & 31, ob = rr * 64 + cc * 2; return st * 1024 + (ob ^ (((ob >> 9) & 1) << 5)); }
__host__ __device__ __forceinline__ void stage_rc(int b, int& R, int& C) { const int st = b / 1024, sb = b % 1024, swz = sb ^ (((sb >> 9) & 1) << 5); R = (st >> 1) * 16 + swz / 64; C = (st & 1) * 32 + (swz % 64) / 2; }
__host__ __device__ __forceinline__ int perm32(int rho) { const int n = rho >> 4, i = rho & 15; return 8 * (i >> 2) + 4 * n + (i & 3); }

struct Unit { int pm, pn, s; };

struct StaticOrder {
    int nM, nN, nwg, G, c;
    __device__ __forceinline__ void init(int M_, int N_, int G_, int c_) { nM = M_ / BM; nN = N_ / BM; nwg = nM * nN; G = G_; c = c_; }
    __device__ __forceinline__ bool next(int i, Unit& u) const {
        const long L = (long)i * G + c; if (L >= nwg) return false;
        int wgid = (int)L; { const int q = nwg / NXCD, r = nwg % NXCD, xcd = wgid % NXCD, off = wgid / NXCD; wgid = (xcd < r ? xcd * (q + 1) : r * (q + 1) + (xcd - r) * q) + off; }
        const int nig = WGM * nN, gid = wgid / nig, fm = gid * WGM, gsz = (nM - fm) < WGM ? (nM - fm) : WGM;
        u.pm = fm + ((wgid % nig) % gsz); u.pn = (wgid % nig) / gsz; u.s = 0; return true;
    }
    __device__ __forceinline__ bool is_short() const { return (nwg % G) != 0 && c >= (nwg % G); }
};
struct PairOrder : StaticOrder {
    __device__ __forceinline__ bool next(int i, Unit& u) const { const bool ok = StaticOrder::next(i >> 1, u); u.s = i & 1; return ok; }
};

template <class Epi, class Sched, class Ops>
__device__ __forceinline__ void gemm_phase(LAS unsigned char* lds, const Ops& P, const int K, const Sched& S, const Epi& E, const unsigned stagger_ticks = 0) {
    if (stagger_ticks && S.is_short()) { const unsigned long long t0_ = __builtin_amdgcn_s_memrealtime(); while (__builtin_amdgcn_s_memrealtime() - t0_ < stagger_ticks) __builtin_amdgcn_s_sleep(8); }
    int tid = threadIdx.x; asm volatile("" : "+v"(tid));
    const int wid = __builtin_amdgcn_readfirstlane(tid >> 6), lane = tid & 63, wr = wid >> 2, wc = wid & 3, fr = lane & 15, fq = lane >> 4;
    const int nt = K / BK;
    unsigned voffA[2], voffB[2];
#pragma unroll
    for (int i = 0; i < 2; ++i) { int R, C; stage_rc(tid * 16 + i * 8192, R, C); const int Rb = Epi::PERM ? ((R & ~31) + perm32(R & 31)) : R;
        voffA[i] = (unsigned)(R * K + C) * 2u; voffB[i] = (unsigned)(Rb * K + C) * 2u; }
    const size_t kstep = (size_t)(BK * 2);
    const size_t hstep = (size_t)HALF * K * 2;
    const unsigned ldsw = (unsigned)wid * 1024u;
    const int aoff = lds_byte(wr * 64 + fr, fq * 8), boff = lds_byte(wc * 32 + fr, fq * 8);
#define PG8_SA(b, h) (((b) * 2 + (h)) * HTB)
#define PG8_SB(b, h) ((4 + (b) * 2 + (h)) * HTB)
#define PG8_STAGE(bufoff, gbase, voff) do { _Pragma("unroll") for (int _i = 0; _i < 2; ++_i) \
        __builtin_amdgcn_global_load_lds((const unsigned*)((const char*)(gbase) + (voff)[_i]), (LAS unsigned*)(lds + (bufoff) + ldsw + _i * 8192), 16, 0, 0); } while (0)
#define PG8_LDA(dst, b, h) do { _Pragma("unroll") for (int m = 0; m < 4; ++m) _Pragma("unroll") for (int k = 0; k < 2; ++k) dst[m][k] = *(const LAS bf16x8*)(lds + PG8_SA(b, h) + aoff + m * 2048 + k * 1024); } while (0)
#define PG8_LDB(dst, b, h) do { _Pragma("unroll") for (int n = 0; n < 2; ++n) _Pragma("unroll") for (int k = 0; k < 2; ++k) dst[n][k] = *(const LAS bf16x8*)(lds + PG8_SB(b, h) + boff + n * 2048 + k * 1024); } while (0)
#define PG8_MMA(ai, bj, At, Bt) do { __builtin_amdgcn_s_setprio(1); _Pragma("unroll") for (int m = 0; m < 4; ++m) _Pragma("unroll") for (int n = 0; n < 2; ++n) _Pragma("unroll") for (int k = 0; k < 2; ++k) \
        acc[ai][bj][m][n] = __builtin_amdgcn_mfma_f32_16x16x32_bf16(Bt[n][k], At[m][k], acc[ai][bj][m][n], 0, 0, 0); __builtin_amdgcn_s_setprio(0); } while (0)
#define PG8_WAIT_V(n) asm volatile("s_waitcnt vmcnt(" #n ")" ::: "memory")
#define PG8_WAIT_L(n) asm volatile("s_waitcnt lgkmcnt(" #n ")" ::: "memory")
#define PG8_BAR __builtin_amdgcn_s_barrier()
#define PG8_SCHED __builtin_amdgcn_sched_barrier(0)
    Unit cur, nxt; int ui = 0;
    if (!S.next(0, cur)) return;
    f32x4 acc[2][2][4][2];
#pragma unroll
    for (int a = 0; a < 2; ++a)
#pragma unroll
        for (int b = 0; b < 2; ++b)
#pragma unroll
            for (int m = 0; m < 4; ++m)
#pragma unroll
                for (int n = 0; n < 2; ++n) acc[a][b][m][n] = (f32x4){0.f, 0.f, 0.f, 0.f};
    bf16x8 At[4][2], B0[2][2], B1[2][2];
    const char* cA = P.a_base(cur); const char* cB = P.b_base(cur);
    PG8_STAGE(PG8_SB(0, 0), cB, voffB); PG8_STAGE(PG8_SB(0, 1), cB + hstep, voffB); PG8_STAGE(PG8_SA(0, 0), cA, voffA); PG8_STAGE(PG8_SA(0, 1), cA + hstep, voffA);
    if (wr == 1) PG8_BAR;
    PG8_WAIT_V(2); PG8_BAR;
    PG8_STAGE(PG8_SB(1, 0), cB + kstep, voffB); PG8_STAGE(PG8_SA(1, 0), cA + kstep, voffA); PG8_STAGE(PG8_SB(1, 1), cB + hstep + kstep, voffB);
    PG8_WAIT_V(6); PG8_BAR;
    for (;;) {
        const bool has_next = S.next(ui + 1, nxt);
        const char* nA = has_next ? P.a_base(nxt) : cA; const char* nB = has_next ? P.b_base(nxt) : cB;
        for (int t = 0; t < nt; t += 2) {
            const bool last = (t == nt - 2);
            const char* a1 = cA + (size_t)(t + 1) * kstep;
            const char* a2 = last ? nA : cA + (size_t)(t + 2) * kstep; const char* b2 = last ? nB : cB + (size_t)(t + 2) * kstep;
            const char* a3 = a2 + kstep; const char* b3 = b2 + kstep;
            PG8_LDB(B0, 0, 0); PG8_LDB(B1, 0, 1); PG8_SCHED; PG8_LDA(At, 0, 0); PG8_STAGE(PG8_SA(1, 1), a1 + hstep, voffA);
            PG8_WAIT_V(8); PG8_WAIT_L(0); PG8_BAR; PG8_MMA(0, 0, At, B0); PG8_MMA(0, 1, At, B1); PG8_BAR; PG8_SCHED;
            PG8_LDA(At, 0, 1); PG8_STAGE(PG8_SB(0, 0), b2, voffB); PG8_STAGE(PG8_SB(0, 1), b2 + hstep, voffB); PG8_STAGE(PG8_SA(0, 0), a2, voffA);
            PG8_WAIT_V(8); PG8_WAIT_L(0); PG8_BAR; PG8_MMA(1, 0, At, B0); PG8_MMA(1, 1, At, B1); PG8_BAR; PG8_SCHED;
            PG8_LDB(B0, 1, 0); PG8_LDB(B1, 1, 1); PG8_SCHED; PG8_LDA(At, 1, 0); PG8_STAGE(PG8_SA(0, 1), a2 + hstep, voffA);
            PG8_WAIT_V(8); PG8_WAIT_L(0); PG8_BAR; PG8_MMA(0, 0, At, B0); PG8_MMA(0, 1, At, B1); PG8_BAR; PG8_SCHED;
            PG8_LDA(At, 1, 1); PG8_STAGE(PG8_SB(1, 0), b3, voffB); PG8_STAGE(PG8_SB(1, 1), b3 + hstep, voffB); PG8_STAGE(PG8_SA(1, 0), a3, voffA);
            PG8_WAIT_V(8); PG8_WAIT_L(0); PG8_BAR; PG8_MMA(1, 0, At, B0); PG8_MMA(1, 1, At, B1); PG8_BAR; PG8_SCHED;
        }
        if (wr == 0) PG8_BAR;
        E(acc, cur, wr, wc, fr, fq);
        if (!has_next) break;
        if (!E.keep(cur)) {
#pragma unroll
            for (int a = 0; a < 2; ++a)
#pragma unroll
                for (int b = 0; b < 2; ++b)
#pragma unroll
                    for (int m = 0; m < 4; ++m)
#pragma unroll
                        for (int n = 0; n < 2; ++n) acc[a][b][m][n] = (f32x4){0.f, 0.f, 0.f, 0.f};
        }
        cur = nxt; cA = nA; cB = nB; ++ui;
        if (wr == 1) PG8_BAR;
    }
    PG8_WAIT_V(0);
    PG8_BAR;
#undef PG8_SA
#undef PG8_SB
#undef PG8_STAGE
#undef PG8_LDA
#undef PG8_LDB
#undef PG8_MMA
#undef PG8_WAIT_V
#undef PG8_WAIT_L
#undef PG8_BAR
#undef PG8_SCHED
}
}

struct OpsPlain { const char* A; const char* Bt; size_t tstep;
    __device__ __forceinline__ const char* a_base(const pg8::Unit& u) const { return A + (size_t)u.pm * tstep; }
    __device__ __forceinline__ const char* b_base(const pg8::Unit& u) const { return Bt + (size_t)u.pn * tstep; } };
struct OpsPair { const char* A0; long dA; const char* B0; long dB; size_t tstep;
    __device__ __forceinline__ const char* a_base(const pg8::Unit& u) const { return A0 + (long)u.s * dA + (size_t)u.pm * tstep; }
    __device__ __forceinline__ const char* b_base(const pg8::Unit& u) const { return B0 + (long)u.s * dB + (size_t)u.pn * tstep; } };


struct EpiIn {
    static constexpr bool PERM = true;
    unsigned char* ws; float* out; const float *qg, *kg;
    __device__ __forceinline__ bool keep(const pg8::Unit&) const { return false; }
    __device__ __forceinline__ void operator()(f32x4 (&acc)[2][2][4][2], const pg8::Unit& u, int wr, int wc, int fr, int fq) const {
        const int pn = u.pn, pm = u.pm; const bool prompt = pm < 32;
        int kind, hcol;
        if (pn < 2) { kind = 0; hcol = (4 * pn + wc) * 64; }
        else if (pn == 2) { if (wc < 2) { kind = 1; hcol = wc * 64; } else { kind = 2; hcol = (wc - 2) * 64; } }
        else if (pn < 5) { kind = 3; hcol = (4 * (pn - 3) + wc) * 64; }
        else if (pn < 7) { kind = 4; hcol = (4 * (pn - 5) + wc) * 64; }
        else if (pn < 9) { kind = 5; hcol = (4 * (pn - 7) + wc) * 64; }
        else if (pn < 13) { kind = 6; hcol = 256 * (pn - 9) + 64 * wc; }
        else { kind = 7; hcol = 256 * (pn - 13) + 64 * wc; }
        bf16_t* dst; int pitch; float* fo = nullptr; bool kvdst = false;
        switch (kind) {
            case 0: dst = (bf16_t*)(ws + WS_QA); pitch = 512; break;
            case 1: dst = (bf16_t*)(ws + WS_KA); pitch = 128; kvdst = true; fo = out + OUT_AK; break;
            case 2: dst = (bf16_t*)(ws + WS_VA); pitch = 128; kvdst = true; fo = out + OUT_AV; break;
            case 3: dst = (bf16_t*)(ws + WS_QB); pitch = 512; break;
            case 4: dst = (bf16_t*)(ws + WS_KB); pitch = 512; kvdst = true; fo = out + OUT_BK; break;
            case 5: dst = (bf16_t*)(ws + WS_VB); pitch = 512; kvdst = true; fo = out + OUT_BV; break;
            case 6: dst = (bf16_t*)(ws + WS_GA); pitch = 1024; break;
            default: dst = (bf16_t*)(ws + WS_GB); pitch = 1024; break;
        }
        const float* ropec = (const float*)(ws + WS_ROPE); const float* ropes = ropec + 1024;
        const bool norm = kind <= 1, rope = norm && !prompt;
        const float qscale = (kind == 0 || kind == 3) ? C2 : 1.0f;
        const int lb = prompt ? 0 : ((pm - 32) >> 4), tb = prompt ? 0 : ((pm - 32) & 15);
        const long rowadd = kvdst ? (prompt ? (long)NBS * KVL : (long)(-MP) + 512L * (lb + 1)) : 0L;
        const float* gsel = ((kind == 0) ? qg : kg) + 8 * fq;
        const int i0 = 8 * (fq & 1);
#pragma unroll
        for (int ai = 0; ai < 2; ++ai) {
            const int grow = 4 * tb + 2 * ai + wr;
#pragma unroll
            for (int m = 0; m < 4; ++m) {
                const int rt = ai * 128 + wr * 64 + m * 16 + fr; const long row = (long)pm * 256 + rt;
                f32x4 v[2][2];
#pragma unroll
                for (int bj = 0; bj < 2; ++bj)
#pragma unroll
                    for (int n = 0; n < 2; ++n) v[bj][n] = acc[ai][bj][m][n];
                if (norm) {
                    float ss = 0.f;
#pragma unroll
                    for (int bj = 0; bj < 2; ++bj)
#pragma unroll
                        for (int n = 0; n < 2; ++n) ss += (v[bj][n][0] * v[bj][n][0] + v[bj][n][1] * v[bj][n][1]) + (v[bj][n][2] * v[bj][n][2] + v[bj][n][3] * v[bj][n][3]);
                    ss += __shfl_xor(ss, 16); ss += __shfl_xor(ss, 32);
                    const float inv = 1.0f / sqrtf(ss * (1.0f / 64.0f) + RMS_EPS);
#pragma unroll
                    for (int bj = 0; bj < 2; ++bj)
#pragma unroll
                        for (int n = 0; n < 2; ++n) v[bj][n] = (v[bj][n] * inv) * *(const f32x4*)(gsel + 32 * bj + 4 * n);
                }
                if (fo && prompt) {
                    float* fp = fo + (size_t)row * pitch + hcol + 8 * fq;
#pragma unroll
                    for (int bj = 0; bj < 2; ++bj)
#pragma unroll
                        for (int n = 0; n < 2; ++n) *(f32x4*)(fp + 32 * bj + 4 * n) = v[bj][n];
                }
                if (rope) {
                    const int gcol = m * 16 + fr;
#pragma unroll
                    for (int bj = 0; bj < 2; ++bj) {
                        const float* tc = ropec + (bj ? gcol : grow) * 16 + i0; const float* ts = ropes + (bj ? gcol : grow) * 16 + i0;
#pragma unroll
                        for (int n = 0; n < 2; ++n) {
                            const f32x4 co = *(const f32x4*)(tc + 4 * n), si = *(const f32x4*)(ts + 4 * n);
                            f32x4 o;
#pragma unroll
                            for (int e = 0; e < 4; ++e) { const float mine = v[bj][n][e], oth = __shfl_xor(mine, 32);
                                o[e] = (fq < 2) ? (mine * co[e] - oth * si[e]) : (oth * si[e] + mine * co[e]); }
                            v[bj][n] = o;
                        }
                    }
                }
                bf16_t* dp = dst + (size_t)(row + rowadd) * pitch + hcol + 8 * fq;
#pragma unroll
                for (int bj = 0; bj < 2; ++bj) {
                    f32x4 a = v[bj][0], b = v[bj][1];
                    if (kind >= 6) {
#pragma unroll
                        for (int e = 0; e < 4; ++e) { a[e] = sigmoidf_(a[e]); b[e] = sigmoidf_(b[e]); }
                    } else { a = a * qscale; b = b * qscale; }
                    u32x4 w; w.x = cvt_pk_bf16(a[0], a[1]); w.y = cvt_pk_bf16(a[2], a[3]); w.z = cvt_pk_bf16(b[0], b[1]); w.w = cvt_pk_bf16(b[2], b[3]);
                    *(u32x4*)(dp + 32 * bj) = w;
                }
                asm volatile("" ::: "memory");
            }
        }
    }
};

struct EpiBr {
    static constexpr bool PERM = true;
    const bf16_t *GA, *GB; bf16_t* MMo;
    __device__ __forceinline__ bool keep(const pg8::Unit& u) const { return u.s == 0; }
    __device__ __forceinline__ void operator()(f32x4 (&acc)[2][2][4][2], const pg8::Unit& u, int wr, int wc, int fr, int fq) const {
        const int col0 = u.pn * 256 + wc * 32 + 8 * fq;
#pragma unroll
        for (int ai = 0; ai < 2; ++ai) {
            const size_t off0 = ((size_t)u.pm * 256 + ai * 128 + wr * 64 + fr) * 1024 + col0;
            u32x4 gb[4][2], ga[4][2];
#pragma unroll
            for (int m = 0; m < 4; ++m)
#pragma unroll
                for (int bj = 0; bj < 2; ++bj) gb[m][bj] = *(const u32x4*)(GB + off0 + (size_t)m * 16 * 1024 + bj * 128);
            if (u.s == 0) {
#pragma unroll
                for (int m = 0; m < 4; ++m)
#pragma unroll
                    for (int bj = 0; bj < 2; ++bj) ga[m][bj] = *(const u32x4*)(GA + off0 + (size_t)m * 16 * 1024 + bj * 128);
#pragma unroll
                for (int m = 0; m < 4; ++m)
#pragma unroll
                    for (int bj = 0; bj < 2; ++bj) {
                        const f32x4 sb0 = {bf_lo(gb[m][bj].x), bf_hi(gb[m][bj].x), bf_lo(gb[m][bj].y), bf_hi(gb[m][bj].y)}, sb1 = {bf_lo(gb[m][bj].z), bf_hi(gb[m][bj].z), bf_lo(gb[m][bj].w), bf_hi(gb[m][bj].w)};
                        const f32x4 sa0 = {bf_lo(ga[m][bj].x), bf_hi(ga[m][bj].x), bf_lo(ga[m][bj].y), bf_hi(ga[m][bj].y)}, sa1 = {bf_lo(ga[m][bj].z), bf_hi(ga[m][bj].z), bf_lo(ga[m][bj].w), bf_hi(ga[m][bj].w)};
                        f32x4 r0, r1;
#pragma unroll
                        for (int e = 0; e < 4; ++e) { r0[e] = sa0[e] * __builtin_amdgcn_rcpf(sb0[e]); r1[e] = sa1[e] * __builtin_amdgcn_rcpf(sb1[e]); }
                        acc[ai][bj][m][0] = acc[ai][bj][m][0] * r0; acc[ai][bj][m][1] = acc[ai][bj][m][1] * r1;
                    }
            } else {
#pragma unroll
                for (int m = 0; m < 4; ++m)
#pragma unroll
                    for (int bj = 0; bj < 2; ++bj) {
                        const f32x4 sb0 = {bf_lo(gb[m][bj].x), bf_hi(gb[m][bj].x), bf_lo(gb[m][bj].y), bf_hi(gb[m][bj].y)}, sb1 = {bf_lo(gb[m][bj].z), bf_hi(gb[m][bj].z), bf_lo(gb[m][bj].w), bf_hi(gb[m][bj].w)};
                        const f32x4 o0 = acc[ai][bj][m][0] * sb0, o1 = acc[ai][bj][m][1] * sb1;
                        u32x4 w; w.x = cvt_pk_bf16(o0[0], o0[1]); w.y = cvt_pk_bf16(o0[2], o0[3]); w.z = cvt_pk_bf16(o1[0], o1[1]); w.w = cvt_pk_bf16(o1[2], o1[3]);
                        *(u32x4*)(MMo + off0 + (size_t)m * 16 * 1024 + bj * 128) = w;
                    }
            }
            asm volatile("" ::: "memory");
        }
    }
};

struct EpiOut {
    static constexpr bool PERM = false;
    const float *xp, *xs, *mod, *n2; float* x1; bf16_t* XW; float* ssq;
    __device__ __forceinline__ bool keep(const pg8::Unit&) const { return false; }
    __device__ __forceinline__ void operator()(f32x4 (&acc)[2][2][4][2], const pg8::Unit& u, int wr, int wc, int fr, int fq) const {
        const int pm = u.pm; const bool prompt = pm < 32; const int mrow = prompt ? 8 : ((pm - 32) >> 4);
        const float* modr = mod + (size_t)mrow * NMOD; const int col0 = u.pn * 256 + wc * 32 + 4 * fq;
        const float* xbase = prompt ? xp : (xs - (size_t)MP * DM);
#pragma unroll
        for (int ai = 0; ai < 2; ++ai) {
            const size_t row0 = (size_t)pm * 256 + ai * 128 + wr * 64 + fr;
            float ss[4] = {0.f, 0.f, 0.f, 0.f};
#pragma unroll
            for (int bj = 0; bj < 2; ++bj) {
                f32x4 xv[4][2], g1[2], w2[2];
#pragma unroll
                for (int m = 0; m < 4; ++m)
#pragma unroll
                    for (int n = 0; n < 2; ++n) xv[m][n] = *(const f32x4*)(xbase + (row0 + m * 16) * DM + col0 + bj * 128 + n * 16);
#pragma unroll
                for (int n = 0; n < 2; ++n) { const int c = col0 + bj * 128 + n * 16; g1[n] = *(const f32x4*)(modr + 2048 + c);
                    const f32x4 sc = *(const f32x4*)(modr + 4096 + c), nn = *(const f32x4*)(n2 + c); w2[n] = nn * (sc + 1.0f); }
#pragma unroll
                for (int m = 0; m < 4; ++m)
#pragma unroll
                    for (int n = 0; n < 2; ++n) { const size_t off = (row0 + m * 16) * DM + col0 + bj * 128 + n * 16;
                        const f32x4 o = xv[m][n] + g1[n] * acc[ai][bj][m][n];
                        *(f32x4*)(x1 + off) = o; ss[m] += (o[0] * o[0] + o[1] * o[1]) + (o[2] * o[2] + o[3] * o[3]);
                        const f32x4 ow = o * w2[n]; u32x2 w; w.x = cvt_pk_bf16(ow[0], ow[1]); w.y = cvt_pk_bf16(ow[2], ow[3]); *(u32x2*)(XW + off) = w; }
                asm volatile("" ::: "memory");
            }
#pragma unroll
            for (int m = 0; m < 4; ++m) { float t = ss[m]; t += __shfl_xor(t, 16); t += __shfl_xor(t, 32); if (fq == 0) ssq[(row0 + m * 16) * 16 + u.pn * 4 + wc] = t; }
        }
    }
};

struct EpiUp {
    static constexpr bool PERM = true;
    const float *ssq, *bup; bf16_t* HID;
    __device__ __forceinline__ bool keep(const pg8::Unit&) const { return false; }
    __device__ __forceinline__ void operator()(f32x4 (&acc)[2][2][4][2], const pg8::Unit& u, int wr, int wc, int fr, int fq) const {
        const int pm = u.pm; const int mrow = pm < 32 ? 8 : ((pm - 32) >> 4); const int col0 = u.pn * 256 + wc * 32 + 8 * fq;
        f32x4 bv[2][2];
#pragma unroll
        for (int bj = 0; bj < 2; ++bj)
#pragma unroll
            for (int n = 0; n < 2; ++n) bv[bj][n] = *(const f32x4*)(bup + (size_t)mrow * FF + col0 + bj * 128 + 4 * n);
#pragma unroll
        for (int ai = 0; ai < 2; ++ai)
#pragma unroll
            for (int m = 0; m < 4; ++m) { const size_t row = (size_t)pm * 256 + ai * 128 + wr * 64 + m * 16 + fr;
                const f32x4* sp = (const f32x4*)(ssq + row * 16); const f32x4 s0 = sp[0], s1 = sp[1], s2 = sp[2], s3 = sp[3];
                const float tot = (((s0[0] + s0[1]) + (s0[2] + s0[3])) + ((s1[0] + s1[1]) + (s1[2] + s1[3]))) + (((s2[0] + s2[1]) + (s2[2] + s2[3])) + ((s3[0] + s3[1]) + (s3[2] + s3[3])));
                const float inv = 1.0f / sqrtf(tot * (1.0f / DM) + RMS_EPS);
#pragma unroll
                for (int bj = 0; bj < 2; ++bj) { f32x4 a = acc[ai][bj][m][0] * inv + bv[bj][0], b = acc[ai][bj][m][1] * inv + bv[bj][1];
#pragma unroll
                    for (int e = 0; e < 4; ++e) { a[e] = fmaxf(a[e], 0.f); a[e] *= a[e]; b[e] = fmaxf(b[e], 0.f); b[e] *= b[e]; }
                    u32x4 w; w.x = cvt_pk_bf16(a[0], a[1]); w.y = cvt_pk_bf16(a[2], a[3]); w.z = cvt_pk_bf16(b[0], b[1]); w.w = cvt_pk_bf16(b[2], b[3]);
                    *(u32x4*)(HID + row * FF + col0 + bj * 128) = w; } }
    }
};

struct EpiDown {
    static constexpr bool PERM = false;
    const float* mod; float* x1;
    __device__ __forceinline__ bool keep(const pg8::Unit&) const { return false; }
    __device__ __forceinline__ void operator()(f32x4 (&acc)[2][2][4][2], const pg8::Unit& u, int wr, int wc, int fr, int fq) const {
        const int pm = u.pm; const int mrow = pm < 32 ? 8 : ((pm - 32) >> 4); const float* modr = mod + (size_t)mrow * NMOD; const int col0 = u.pn * 256 + wc * 32 + 4 * fq;
#pragma unroll
        for (int ai = 0; ai < 2; ++ai) {
            const size_t row0 = (size_t)pm * 256 + ai * 128 + wr * 64 + fr;
#pragma unroll
            for (int bj = 0; bj < 2; ++bj) {
                f32x4 xv[4][2], g2[2];
#pragma unroll
                for (int m = 0; m < 4; ++m)
#pragma unroll
                    for (int n = 0; n < 2; ++n) xv[m][n] = *(const f32x4*)(x1 + (row0 + m * 16) * DM + col0 + bj * 128 + n * 16);
#pragma unroll
                for (int n = 0; n < 2; ++n) g2[n] = *(const f32x4*)(modr + 5120 + col0 + bj * 128 + n * 16);
#pragma unroll
                for (int m = 0; m < 4; ++m)
#pragma unroll
                    for (int n = 0; n < 2; ++n) *(f32x4*)(x1 + (row0 + m * 16) * DM + col0 + bj * 128 + n * 16) = xv[m][n] + g2[n] * acc[ai][bj][m][n];
                asm volatile("" ::: "memory");
            }
        }
    }
};

namespace attn_body {
using bf16 = __hip_bfloat16;
using s16x4 = __attribute__((ext_vector_type(4))) short;
using f32x16 = __attribute__((ext_vector_type(16))) float;
constexpr int D = 64, NW = 8, QBLK = 32, QB = QBLK * NW, KVBLK = 64;
__device__ __forceinline__ int crow(int r, int hi) { return (r & 3) + 8 * (r >> 2) + 4 * hi; }
#define SBAR() __builtin_amdgcn_sched_barrier(0)
constexpr int NSLOT = 3, SLOTB = 8192;
constexpr int LDS_K = 0, LDS_V = NSLOT * SLOTB, LDS_WS = 2 * NSLOT * SLOTB, LDS_OST = LDS_WS + NW * 64 * 4, LDS_BYTES = LDS_OST + NW * 4096;
constexpr int LDS_MASK = 120320;
constexpr int LDS_TAB = 86016;
__device__ __forceinline__ void glds16(const void* sbase, unsigned voff, unsigned lds_dst) { unsigned keep;
    asm volatile("s_nop 4\n\ts_mov_b32 %0, m0\n\ts_mov_b32 m0, %3\n\ts_nop 0\n\tglobal_load_lds_dwordx4 %1, %2\n\ts_mov_b32 m0, %0" : "=&s"(keep) : "v"(voff), "s"(sbase), "s"(lds_dst) : "memory"); }
__device__ __forceinline__ float max3f(float a, float b, float c) { float r; asm("v_max3_f32 %0, %1, %2, %3" : "=v"(r) : "v"(a), "v"(b), "v"(c)); return r; }
__device__ __forceinline__ float max2f(float a, float b) { float r; asm("v_max_f32_e32 %0, %1, %2" : "=v"(r) : "v"(a), "v"(b)); return r; }
__device__ __forceinline__ float fadd_s(float a, float b) { float r; asm("v_add_f32_e32 %0, %1, %2" : "=v"(r) : "v"(a), "v"(b)); return r; }
__device__ __forceinline__ float fsub_s(float a, float b) { float r; asm("v_sub_f32_e32 %0, %1, %2" : "=v"(r) : "v"(a), "v"(b)); return r; }
typedef float f32x2_t __attribute__((ext_vector_type(2))); typedef __bf16 bf16x2_t __attribute__((ext_vector_type(2)));
__device__ __forceinline__ unsigned cvtpk_s(float lo, float hi) { f32x2_t v = {lo, hi}; bf16x2_t b = __builtin_convertvector(v, bf16x2_t); return __builtin_bit_cast(unsigned, b); }
#define WAIT_BAR(N) asm volatile("s_waitcnt vmcnt(" #N ") lgkmcnt(0)\n\ts_barrier" ::: "memory")

__device__ __forceinline__ void qkt(f32x16& p0, f32x16& p1, const char* Kslot, const bf16x8* qr, const f32x16& negm, int r32, int hi) {
    const char* kb = Kslot + hi * 1024 + r32 * 16;
#pragma unroll
    for (int d0 = 0; d0 < 4; ++d0) {
        const bf16x8 b0 = *reinterpret_cast<const bf16x8*>(kb + d0 * 2048);
        const bf16x8 b1 = *reinterpret_cast<const bf16x8*>(kb + d0 * 2048 + 512);
        if (d0 == 0) { p0 = __builtin_amdgcn_mfma_f32_32x32x16_bf16(b0, qr[0], negm, 0, 0, 0); p1 = __builtin_amdgcn_mfma_f32_32x32x16_bf16(b1, qr[0], negm, 0, 0, 0); }
        else { p0 = __builtin_amdgcn_mfma_f32_32x32x16_bf16(b0, qr[d0], p0, 0, 0, 0); p1 = __builtin_amdgcn_mfma_f32_32x32x16_bf16(b1, qr[d0], p1, 0, 0, 0); } }
}
typedef __attribute__((address_space(3))) const char* lds_cptr;
typedef short v4i16_t __attribute__((ext_vector_type(4)));
__device__ __forceinline__ void kload8(bf16x8* kf, lds_cptr kp) {
    kf[0] = *(const LAS bf16x8*)(kp);        kf[1] = *(const LAS bf16x8*)(kp + 512);
    kf[2] = *(const LAS bf16x8*)(kp + 2048); kf[3] = *(const LAS bf16x8*)(kp + 2560);
    kf[4] = *(const LAS bf16x8*)(kp + 4096); kf[5] = *(const LAS bf16x8*)(kp + 4608);
    kf[6] = *(const LAS bf16x8*)(kp + 6144); kf[7] = *(const LAS bf16x8*)(kp + 6656);
}
__device__ __forceinline__ void kload2(bf16x8* kf, lds_cptr kp, int j) { kf[2 * j] = *(const LAS bf16x8*)(kp + j * 2048); kf[2 * j + 1] = *(const LAS bf16x8*)(kp + j * 2048 + 512); }
__device__ __forceinline__ s16x4 vtr(lds_cptr p) { return __builtin_bit_cast(s16x4, __builtin_amdgcn_ds_read_tr16_b64_v4i16((LAS v4i16_t*)p)); }
__device__ __forceinline__ float rowmax(const f32x16& p0, const f32x16& p1) {
    float a = max3f(p0[0], p0[1], p1[0]), b = max3f(p0[2], p0[3], p1[1]); a = max3f(a, p1[2], p1[3]);
#pragma unroll
    for (int r = 4; r < 16; r += 4) { a = max3f(a, p0[r], p0[r + 1]); b = max3f(b, p0[r + 2], p0[r + 3]); a = max3f(a, p1[r], p1[r + 1]); b = max3f(b, p1[r + 2], p1[r + 3]); }
    const float m = max2f(a, b);
    auto rr = __builtin_amdgcn_permlane32_swap(__float_as_uint(m), __float_as_uint(m), false, false);
    return max2f(__uint_as_float(rr[0]), __uint_as_float(rr[1]));
}
__device__ __forceinline__ void pv(f32x16* o, int vb, bf16x8 pa0, bf16x8 pa1, bf16x8 pa2, bf16x8 pa3) {
#pragma unroll
    for (int d0 = 0; d0 < 2; ++d0) { s16x4 lo[4], hi[4];
#pragma unroll
        for (int ks = 0; ks < 4; ++ks) {
            asm volatile("ds_read_b64_tr_b16 %0,%1 offset:%c2" : "=&v"(lo[ks]) : "v"(vb), "i"(d0 * 4096 + ks * 1024) : "memory");
            asm volatile("ds_read_b64_tr_b16 %0,%1 offset:%c2" : "=&v"(hi[ks]) : "v"(vb), "i"(d0 * 4096 + ks * 1024 + 512) : "memory"); }
        asm volatile("s_waitcnt lgkmcnt(0)" ::: "memory"); SBAR();
#define PK(k) (bf16x8){lo[k][0], lo[k][1], lo[k][2], lo[k][3], hi[k][0], hi[k][1], hi[k][2], hi[k][3]}
        o[d0] = __builtin_amdgcn_mfma_f32_32x32x16_bf16(pa0, PK(0), o[d0], 0, 0, 0);
        o[d0] = __builtin_amdgcn_mfma_f32_32x32x16_bf16(pa1, PK(1), o[d0], 0, 0, 0);
        o[d0] = __builtin_amdgcn_mfma_f32_32x32x16_bf16(pa2, PK(2), o[d0], 0, 0, 0);
        o[d0] = __builtin_amdgcn_mfma_f32_32x32x16_bf16(pa3, PK(3), o[d0], 0, 0, 0);
#undef PK
    }
}

struct AttnDesc { const bf16* Qw0; bf16* Ow0; const bf16* Kh; const bf16* Vh; int qp, kp, NT, lo, qrow0; };

constexpr int TABR = 132, TABC = 2128;
constexpr int MSKR = 68;
template <int HK> __device__ __forceinline__ void nb_hook(f32x16& C0, f32x16& C1, int t, int lo, int qrow, int qc, int hi, float mhat, const LAS float* tab, const LAS float* maskT) {
    if (HK == 0) {
#pragma unroll
        for (int r = 0; r < 16; ++r) { C0[r] -= mhat; C1[r] -= mhat; }
    } else {
        const int kr = lo + t - 8;
        int rs = qrow - 4; rs = rs < 0 ? 0 : (rs > 56 ? 56 : rs);
        const bool rowok = (kr >= rs && kr < rs + 8);
        const int dr = rowok ? (kr - qrow + 7) : 15;
        const LAS f32x4* bp = (const LAS f32x4*)(tab + (qc & 3) * (TABC + 1) + dr * TABR + (64 + 4 * hi - qc));
        const LAS f32x4* mp = (const LAS f32x4*)(maskT + (rowok ? qc : 64) * MSKR + 4 * hi);
        {   f32x4 b[4];
#pragma unroll
            for (int g = 0; g < 4; ++g) b[g] = bp[2 * g] + mp[2 * g];
#pragma unroll
            for (int g = 0; g < 4; ++g)
#pragma unroll
                for (int e = 0; e < 4; ++e) { const int r = 4 * g + e; C0[r] += b[g][e] - mhat; }
        }
        __builtin_amdgcn_sched_barrier(0);
        {   f32x4 b[4];
#pragma unroll
            for (int g = 0; g < 4; ++g) b[g] = bp[2 * g + 8] + mp[2 * g + 8];
#pragma unroll
            for (int g = 0; g < 4; ++g)
#pragma unroll
                for (int e = 0; e < 4; ++e) { const int r = 4 * g + e; C1[r] += b[g][e] - mhat; }
        }
    }
}

#define ATTN_STORE16(p, v) (*(u32x4*)(p) = (v))
template <int MODE, int THRL> __device__ __forceinline__ void attn_unit(const AttnDesc& ds, char* shm) {
    int tid = threadIdx.x; asm volatile("" : "+v"(tid));
    const int lane = tid & 63, r32 = lane & 31, hi = lane >> 5; const int wid = __builtin_amdgcn_readfirstlane(tid >> 6);
    const int qp = ds.qp, kp = ds.kp, NT = ds.NT, lo = ds.lo;
    const bf16* Qw = ds.Qw0 + (long)(wid * QBLK) * qp;
    const bf16* Kh = ds.Kh; const bf16* Vh = ds.Vh;
    const unsigned lds0 = (unsigned)(uintptr_t)shm;
    float* wsf = (float*)(shm + LDS_WS) + wid * 64;
#define KOFF(l_) ((unsigned)(((l_) * kp + wid * 8) * 2))
#define VOFF(l_) ((unsigned)(((16 * (wid & 3) + ((l_) >> 2)) * kp + (wid >> 2) * 32 + ((l_) & 3) * 8) * 2))
    const unsigned koff = KOFF(lane), voff = VOFF(lane);
    const unsigned kdst = lds0 + LDS_K + wid * 1024, vdst = lds0 + LDS_V + wid * 1024;
    const long tstride = (long)KVBLK * kp;
#define TROW(t) ((long)((t) + ((MODE == 1 && (t) >= 8) ? lo : 0)) * tstride)
#define LANE_FRESH() ({ int l_ = (int)__builtin_amdgcn_mbcnt_hi(~0u, __builtin_amdgcn_mbcnt_lo(~0u, 0u)); asm volatile("" : "+v"(l_)); l_; })
#define DMA_K(t, slot) glds16(Kh + TROW(t), (MODE == 1) ? KOFF(LANE_FRESH()) : koff, (unsigned)__builtin_amdgcn_readfirstlane(kdst + (slot)))
#define DMA_V(t, slot) glds16(Vh + TROW(t), (MODE == 1) ? VOFF(LANE_FRESH()) : voff, (unsigned)__builtin_amdgcn_readfirstlane(vdst + (slot)))
    const int vb0 = (int)(lds0 + LDS_V) + ((lane >> 4) & 1) * 32 + (lane & 3) * 8 + (4 * hi + ((lane & 15) >> 2)) * 64;
    const char* Kbase = shm + LDS_K; bf16x8 kf[8];
    const lds_cptr shm3 = (lds_cptr)shm; const lds_cptr kp0 = shm3 + LDS_K + hi * 1024 + r32 * 16; const lds_cptr vp0 = shm3 + LDS_V + ((lane >> 4) & 1) * 32 + (lane & 3) * 8 + (4 * hi + ((lane & 15) >> 2)) * 64;
    const LAS float* tab = (const LAS float*)(shm3 + LDS_TAB); const LAS float* maskT = (const LAS float*)(shm3 + LDS_MASK);
    const int qrow = ds.qrow0 + (wid >> 1), qc = (wid & 1) * 32 + r32;
    DMA_K(0, 0); DMA_V(0, 0); DMA_K(1, SLOTB);
    bf16x8 qr[4];
#pragma unroll
    for (int d0 = 0; d0 < 4; ++d0) qr[d0] = *reinterpret_cast<const bf16x8*>(&Qw[(long)r32 * qp + d0 * 16 + hi * 8]);
    float mhat = 0.f, l_reg = 0.f; f32x16 o[2]; o[0] = f32x16{}; o[1] = f32x16{}; f32x16 negm = f32x16{}; if (MODE == 0) asm volatile("" : "+v"(negm));
#define CMASK(P0, P1, t, HK) do { if (MODE == 1) nb_hook<HK>(P0, P1, (t), lo, qrow, qc, hi, mhat, tab, maskT); } while (0)
    bool resc = false;
#define START(P0, P1) do { const float rm = rowmax(P0, P1); resc = false; \
    { const float dl = rm; mhat = fadd_s(mhat, dl); \
      _Pragma("unroll") for (int r = 0; r < 16; ++r) { P0[r] = fsub_s(P0[r], dl); P1[r] = fsub_s(P1[r], dl); } \
      if (MODE == 0) { _Pragma("unroll") for (int r = 0; r < 16; ++r) negm[r] = -mhat; asm volatile("" : "+v"(negm)); } } \
    _Pragma("unroll") for (int r = 0; r < 16; ++r) P0[r] = __builtin_amdgcn_exp2f(P0[r]); } while (0)
#define RESC() do { if (resc) { asm volatile("s_waitcnt lgkmcnt(0)" ::: "memory"); \
      _Pragma("unroll") for (int d_ = 0; d_ < 2; ++d_) _Pragma("unroll") for (int r = 0; r < 16; ++r) o[d_][r] *= wsf[crow(r, hi)]; } } while (0)
    f32x16 pA0, pA1, pB0, pB1;
    int sl_prev = 0, sl_cur = 0, sl_next = SLOTB;
#define ROT() do { sl_prev = sl_cur; sl_cur = sl_next; sl_next = (sl_next == (NSLOT - 1) * SLOTB) ? 0 : sl_next + SLOTB; } while (0)
    DMA_K(2, 2 * SLOTB);
    WAIT_BAR(3);
    qkt(pA0, pA1, Kbase, qr, negm, r32, hi); asm volatile("s_nop 15\n\ts_nop 7" : "+v"(pA0), "+v"(pA1));
    START(pA0, pA1);
    _Pragma("unroll") for (int r = 0; r < 16; ++r) pA1[r] = __builtin_amdgcn_exp2f(pA1[r]);
    WAIT_BAR(0);
    DMA_K(3, 0); DMA_V(1, SLOTB);
    ROT();
    kload8(kf, kp0 + sl_cur);
    WAIT_BAR(2);
    s16x4 vlo[8], vhi[8]; u32x4 pw0, pw1, pw2, pw3;
#define PKW(P, B) cvtpk_s(P[B], P[B + 1])
#define PAF(k) __builtin_bit_cast(bf16x8, pw##k)
#define VFR(i) (bf16x8){vlo[i][0], vlo[i][1], vlo[i][2], vlo[i][3], vhi[i][0], vhi[i][1], vhi[i][2], vhi[i][3]}
#define PIN(x) asm volatile("" : "+v"(x))
#define MX3(a, b, c) __builtin_fmaxf(__builtin_fmaxf((a), (b)), (c))
#define GAPA(MF, A0, A1, A2, A3, W0, W1, PW) do { MF; sacc += A0; sacc += A1; sacc += A2; sacc += A3; PIN(sacc); W0; W1; PIN(PW); SBAR(); } while (0)
#define EX(v) __builtin_amdgcn_exp2f(v)
#define GAPB(MF, X, B) do { MF; X[B] = EX(X[B]); X[B + 1] = EX(X[B + 1]); X[B + 2] = EX(X[B + 2]); X[B + 3] = EX(X[B + 3]); PIN(X); SBAR(); } while (0)
#define VRD(i) do { vlo[i] = vtr(vp_ + (((i) >> 2) * 4096 + ((i) & 3) * 1024)); vhi[i] = vtr(vp_ + (((i) >> 2) * 4096 + ((i) & 3) * 1024 + 512)); } while (0)
#define KRD(G, j) do { if (G) { kload2(kf, kp0 + sl_next, j); SBAR(); } } while (0)
#define STEP(C0, C1, P0, P1, t, GK, GV, GL, HK) do { SBAR(); \
    const lds_cptr vp_ = vp0 + sl_prev; \
    VRD(0); SBAR(); float sacc = (P0[0] + P0[1]); \
    GAPA(C0 = __builtin_amdgcn_mfma_f32_32x32x16_bf16(kf[0], qr[0], negm, 0, 0, 0), P0[2], P0[3], P0[4], P0[5],     pw0[0] = PKW(P0, 0), pw0[1] = PKW(P0, 2), pw0); \
    VRD(4); SBAR(); GAPA(C1 = __builtin_amdgcn_mfma_f32_32x32x16_bf16(kf[1], qr[0], negm, 0, 0, 0), P0[6], P0[7], P0[8], P0[9],     pw0[2] = PKW(P0, 4), pw0[3] = PKW(P0, 6), pw0); \
    VRD(1); SBAR(); GAPA(C0 = __builtin_amdgcn_mfma_f32_32x32x16_bf16(kf[2], qr[1], C0, 0, 0, 0),   P0[10], P0[11], P0[12], P0[13], pw1[0] = PKW(P0, 8), pw1[1] = PKW(P0, 10), pw1); \
    VRD(5); SBAR(); GAPA(C1 = __builtin_amdgcn_mfma_f32_32x32x16_bf16(kf[3], qr[1], C1, 0, 0, 0),   P0[14], P0[15], P1[0], P1[1],   pw1[2] = PKW(P0, 12), pw1[3] = PKW(P0, 14), pw1); \
    VRD(2); SBAR(); GAPA(C0 = __builtin_amdgcn_mfma_f32_32x32x16_bf16(kf[4], qr[2], C0, 0, 0, 0),   P1[2], P1[3], P1[4], P1[5],     pw2[0] = PKW(P1, 0), pw2[1] = PKW(P1, 2), pw2); \
    VRD(6); SBAR(); GAPA(C1 = __builtin_amdgcn_mfma_f32_32x32x16_bf16(kf[5], qr[2], C1, 0, 0, 0),   P1[6], P1[7], P1[8], P1[9],     pw2[2] = PKW(P1, 4), pw2[3] = PKW(P1, 6), pw2); \
    VRD(3); SBAR(); GAPA(C0 = __builtin_amdgcn_mfma_f32_32x32x16_bf16(kf[6], qr[3], C0, 0, 0, 0),   P1[10], P1[11], P1[12], P1[13], pw3[0] = PKW(P1, 8), pw3[1] = PKW(P1, 10), pw3); \
    VRD(7); SBAR(); GAPA(C1 = __builtin_amdgcn_mfma_f32_32x32x16_bf16(kf[7], qr[3], C1, 0, 0, 0),   P1[14], P1[15], 0.f, 0.f,       pw3[2] = PKW(P1, 12), pw3[3] = PKW(P1, 14), pw3); \
    l_reg += sacc; \
    if (GK) { DMA_K((t) + 3, sl_cur); } if (GV) { DMA_V((t) + 1, sl_next); } \
    CMASK(C0, C1, t, HK); \
    { float a = MX3(C0[0], C0[1], C1[0]), b = MX3(C0[2], C0[3], C1[1]); a = MX3(a, C1[2], C1[3]); \
      _Pragma("unroll") for (int r = 4; r < 16; r += 4) { a = MX3(a, C0[r], C0[r + 1]); b = MX3(b, C0[r + 2], C0[r + 3]); a = MX3(a, C1[r], C1[r + 1]); b = MX3(b, C1[r + 2], C1[r + 3]); } \
      float rm = __builtin_fmaxf(a, b); { auto rr = __builtin_amdgcn_permlane32_swap(__float_as_uint(rm), __float_as_uint(rm), false, false); rm = __builtin_fmaxf(__uint_as_float(rr[0]), __uint_as_float(rr[1])); } \
      resc = false; \
      if (__builtin_expect(__any(rm > (float)THRL), 0)) { const float dl = __builtin_fmaxf(rm, 0.f); mhat += dl; \
        _Pragma("unroll") for (int r = 0; r < 16; ++r) { C0[r] -= dl; C1[r] -= dl; } \
        if (MODE == 0) { _Pragma("unroll") for (int r = 0; r < 16; ++r) negm[r] = -mhat; asm volatile("" : "+v"(negm)); } \
        const float f = __builtin_amdgcn_exp2f(-dl); l_reg *= f; if (hi == 0) wsf[r32] = f; resc = true; } } \
    SBAR(); \
    GAPB(o[0] = __builtin_amdgcn_mfma_f32_32x32x16_bf16(PAF(0), VFR(0), o[0], 0, 0, 0), C0, 0); \
    GAPB(o[1] = __builtin_amdgcn_mfma_f32_32x32x16_bf16(PAF(0), VFR(4), o[1], 0, 0, 0), C0, 4); \
    KRD(GL, 0); GAPB(o[0] = __builtin_amdgcn_mfma_f32_32x32x16_bf16(PAF(1), VFR(1), o[0], 0, 0, 0), C0, 8); \
    KRD(GL, 1); GAPB(o[1] = __builtin_amdgcn_mfma_f32_32x32x16_bf16(PAF(1), VFR(5), o[1], 0, 0, 0), C0, 12); \
    KRD(GL, 2); GAPB(o[0] = __builtin_amdgcn_mfma_f32_32x32x16_bf16(PAF(2), VFR(2), o[0], 0, 0, 0), C1, 0); \
    KRD(GL, 3); GAPB(o[1] = __builtin_amdgcn_mfma_f32_32x32x16_bf16(PAF(2), VFR(6), o[1], 0, 0, 0), C1, 4); \
    GAPB(o[0] = __builtin_amdgcn_mfma_f32_32x32x16_bf16(PAF(3), VFR(3), o[0], 0, 0, 0), C1, 8); \
    GAPB(o[1] = __builtin_amdgcn_mfma_f32_32x32x16_bf16(PAF(3), VFR(7), o[1], 0, 0, 0), C1, 12); \
    } while (0)
    int t = 1;
    if (MODE == 1) {
        for (; t < 7; t += 2) {
            STEP(pB0, pB1, pA0, pA1, t, true, true, true, 0);     WAIT_BAR(2); RESC(); ROT();
            STEP(pA0, pA1, pB0, pB1, t + 1, true, true, true, 0); WAIT_BAR(2); RESC(); ROT();
        }
        STEP(pB0, pB1, pA0, pA1, t, true, true, true, 0);     WAIT_BAR(2); RESC(); ROT();
        STEP(pA0, pA1, pB0, pB1, t + 1, true, true, true, 1); WAIT_BAR(2); RESC(); ROT();
        t += 2;
    }
    for (; t + 5 < NT; t += 2) {
        STEP(pB0, pB1, pA0, pA1, t, true, true, true, 1);     WAIT_BAR(2); RESC(); ROT();
        STEP(pA0, pA1, pB0, pB1, t + 1, true, true, true, 1); WAIT_BAR(2); RESC(); ROT();
    }
#define ENDW(tt) do { if ((tt) + 3 < NT) { WAIT_BAR(2); } else if ((tt) + 2 < NT) { WAIT_BAR(1); } else { WAIT_BAR(0); } } while (0)
    for (; t + 1 < NT; t += 2) {
        STEP(pB0, pB1, pA0, pA1, t, (t + 3 < NT), (t + 1 < NT), (t + 1 < NT), 1);     ENDW(t);     RESC(); ROT();
        STEP(pA0, pA1, pB0, pB1, t + 1, (t + 4 < NT), (t + 2 < NT), (t + 2 < NT), 1); ENDW(t + 1); RESC(); ROT();
    }
    STEP(pB0, pB1, pA0, pA1, NT - 1, false, false, false, 1); RESC();
    { float sacc = pB0[0] + pB0[1]; _Pragma("unroll") for (int r = 2; r < 16; ++r) sacc += pB0[r]; _Pragma("unroll") for (int r = 0; r < 16; ++r) sacc += pB1[r]; l_reg += sacc;
      pw0 = (u32x4){PKW(pB0, 0), PKW(pB0, 2), PKW(pB0, 4), PKW(pB0, 6)}; pw1 = (u32x4){PKW(pB0, 8), PKW(pB0, 10), PKW(pB0, 12), PKW(pB0, 14)}; pw2 = (u32x4){PKW(pB1, 0), PKW(pB1, 2), PKW(pB1, 4), PKW(pB1, 6)}; pw3 = (u32x4){PKW(pB1, 8), PKW(pB1, 10), PKW(pB1, 12), PKW(pB1, 14)};
      SBAR(); pv(o, vb0 + sl_cur, PAF(0), PAF(1), PAF(2), PAF(3)); }
#undef PKW
#undef PAF
#undef VFR
#undef PIN
#undef MX3
#undef GAPA
#undef GAPB
#undef EX
#undef VRD
#undef KRD
#undef STEP
#undef ENDW
    { auto rr = __builtin_amdgcn_permlane32_swap(__float_as_uint(l_reg), __float_as_uint(l_reg), false, false); l_reg = __uint_as_float(rr[0]) + __uint_as_float(rr[1]); }
    if (hi == 0) wsf[32 + r32] = l_reg; asm volatile("s_waitcnt lgkmcnt(0)" ::: "memory");
    float rli[16];
#pragma unroll
    for (int r = 0; r < 16; ++r) rli[r] = __builtin_amdgcn_rcpf(wsf[32 + crow(r, hi)]);
    bf16* Ow = ds.Ow0 + (long)(wid * QBLK) * qp;
    { bf16* stg = (bf16*)(shm + LDS_OST) + wid * 2048;
#pragma unroll
      for (int r = 0; r < 16; ++r) { const int orow = crow(r, hi);
#pragma unroll
          for (int d0 = 0; d0 < 2; ++d0) stg[orow * 64 + d0 * 32 + r32] = __float2bfloat16(o[d0][r] * rli[r]); }
      asm volatile("s_waitcnt lgkmcnt(0)" ::: "memory");
#pragma unroll
      for (int i = 0; i < 4; ++i) { const int row = i * 8 + (lane >> 3), ch = lane & 7; const u32x4 v = *(const u32x4*)(stg + row * 64 + ch * 8); ATTN_STORE16(Ow + (long)row * qp + ch * 8, v); } }
    asm volatile("s_waitcnt lgkmcnt(0)\n\ts_barrier" ::: "memory");
#undef DMA_K
#undef DMA_V
#undef LANE_FRESH
#undef KOFF
#undef VOFF
#undef TROW
#undef CMASK
#undef START
#undef RESC
#undef ROT
}
#undef SBAR
#undef WAIT_BAR
}

typedef GAS unsigned gu32;
#define RLX_AGENT __ATOMIC_RELAXED, __HIP_MEMORY_SCOPE_AGENT
#define XB_TMO      128
#define XB_XCNT(j)  (256  + 64 * (j))
#define XB_XSUB(j)  (1280 + 64 * (j))
#define XB_XGEN(j)  (2304 + 64 * (j))
#define XB_TOP      3328
#define XB_TOPGEN   3392
#define XCD_BAR_WORDS 3456
#define XB_SPIN_CAP (1u << 18)

__device__ __forceinline__ unsigned xb_ld(unsigned* p)              { return __hip_atomic_load(p, __ATOMIC_RELAXED, __HIP_MEMORY_SCOPE_AGENT); }
__device__ __forceinline__ unsigned xb_add(unsigned* p, unsigned v) { return __hip_atomic_fetch_add(p, v, __ATOMIC_RELAXED, __HIP_MEMORY_SCOPE_AGENT); }
__device__ __forceinline__ unsigned xb_xcc_id() { return (unsigned)__builtin_amdgcn_s_getreg((3 << 11) | 20) & 0xFu; }
#define XB_SPIN(cond, bar) do { unsigned _sp = 0; while (cond) { __builtin_amdgcn_s_sleep(1); \
    if ((++_sp & 255u) == 0u) { if (xb_ld(&(bar)[XB_TMO])) break; if (_sp > XB_SPIN_CAP) { atomicAdd(&(bar)[XB_TMO], 1u); break; } } } } while (0)

struct XcdBarrier {
    unsigned* bar; unsigned x;
    volatile LAS unsigned* st;
};

__device__ __forceinline__ XcdBarrier xcd_barrier_post(unsigned* bar, volatile LAS unsigned* st) {
    XcdBarrier b; b.bar = bar; b.x = xb_xcc_id(); b.st = st;
    if (threadIdx.x == 0) (void)xb_add(&bar[XB_XCNT(b.x)], 1u);
    return b;
}
__device__ __forceinline__ void xcd_barrier_complete(unsigned* bar, unsigned x, unsigned& nloc, unsigned& nx) {
    const unsigned G = gridDim.x * gridDim.y * gridDim.z;
    unsigned sum, cnt, mine, sp = 0u;
    for (;;) {
        sum = 0u; cnt = 0u; mine = 0u;
#pragma unroll
        for (unsigned j = 0; j < 16; ++j) { const unsigned c = xb_ld(&bar[XB_XCNT(j)]); sum += c; cnt += (c > 0u) ? 1u : 0u; mine = (j == x) ? c : mine; }
        if (sum == G) break;
        __builtin_amdgcn_s_sleep(1);
        if ((++sp & 255u) == 0u) { if (xb_ld(&bar[XB_TMO])) break; if (sp > XB_SPIN_CAP) { atomicAdd(&bar[XB_TMO], 1u); break; } }
    }
    nloc = mine > 0u ? mine : 1u; nx = cnt > 0u ? cnt : 1u;
}

__device__ __forceinline__ void xcd_barrier(const XcdBarrier& b) {
    asm volatile("s_waitcnt vmcnt(0)" ::: "memory");
    __syncthreads();
    if (threadIdx.x == 0) {
        unsigned* bar = b.bar;
        __builtin_amdgcn_s_waitcnt(0);
        unsigned nloc = b.st[0], nx = b.st[1];
        if (nloc == 0u) { xcd_barrier_complete(bar, b.x, nloc, nx); b.st[0] = nloc; b.st[1] = nx; }
        const unsigned old = xb_add(&bar[XB_XSUB(b.x)], 1u);
        const unsigned gen = old / nloc;
        if (old + 1u == (gen + 1u) * nloc) {
            __builtin_amdgcn_fence(__ATOMIC_RELEASE, "agent");
            asm volatile("s_waitcnt vmcnt(0)" ::: "memory");
            const unsigned og = xb_add(&bar[XB_TOP], 1u);
            const unsigned tg = og / nx;
            if (og + 1u == (tg + 1u) * nx) xb_add(&bar[XB_TOPGEN], 1u);
            else XB_SPIN(xb_ld(&bar[XB_TOPGEN]) == tg, bar);
            __builtin_amdgcn_fence(__ATOMIC_ACQUIRE, "agent");
            xb_add(&bar[XB_XGEN(b.x)], 1u);
            asm volatile("s_waitcnt vmcnt(0)" ::: "memory");
        } else {
            XB_SPIN(xb_ld(&bar[XB_XGEN(b.x)]) == gen, bar);
            __builtin_amdgcn_fence(__ATOMIC_ACQUIRE, "agent");
            asm volatile("s_waitcnt vmcnt(0)" ::: "memory");
        }
    }
    __syncthreads();
}


constexpr int RING_BYTES = 131072;
constexpr int LDS_BYTES = 147456;
constexpr int LDS_MISC = 146432;
constexpr int NWAVES = 8;
constexpr int NPHASE = 9;

struct Frame {
    LAS unsigned char* lds; int tid, lane, wave, vcu, G;
};

__device__ __forceinline__ unsigned f2bf(float f) { unsigned u = __builtin_bit_cast(unsigned, f); return (u + 0x7fffu + ((u >> 16) & 1u)) >> 16; }
__device__ __forceinline__ unsigned pk2(float lo, float hi) { return f2bf(lo) | (f2bf(hi) << 16); }

__device__ __forceinline__ void gemv9_item(const LAS float* Sl, LAS float* red, const float* W, int ldw, int col0, float* out, int ldo, const float* bias, int tid) {
    const int col = tid & 63, kq = tid >> 6;
    float a0 = 0.f, a1 = 0.f, a2 = 0.f, a3 = 0.f, a4 = 0.f, a5 = 0.f, a6 = 0.f, a7 = 0.f, a8 = 0.f;
    const float* wp = W + (size_t)(kq * 128) * ldw + col0 + col;
    for (int kb = 0; kb < 128; kb += 16) {
        float w[16];
#pragma unroll
        for (int kk = 0; kk < 16; ++kk) w[kk] = wp[(size_t)(kb + kk) * ldw];
#pragma unroll
        for (int kk = 0; kk < 16; ++kk) {
            const LAS f32x4* sp = (const LAS f32x4*)(Sl + (kq * 128 + kb + kk) * 12);
            const f32x4 s0 = sp[0], s1 = sp[1], s2 = sp[2]; const float wv = w[kk];
            a0 += s0[0] * wv; a1 += s0[1] * wv; a2 += s0[2] * wv; a3 += s0[3] * wv; a4 += s1[0] * wv; a5 += s1[1] * wv; a6 += s1[2] * wv; a7 += s1[3] * wv; a8 += s2[0] * wv;
        }
    }
    LAS float* rp = red + (kq * 9) * 64 + col;
    rp[0] = a0; rp[64] = a1; rp[128] = a2; rp[192] = a3; rp[256] = a4; rp[320] = a5; rp[384] = a6; rp[448] = a7; rp[512] = a8;
    __syncthreads();
    for (int i = tid; i < 576; i += 512) { const int r = i >> 6, c = i & 63; float s = 0.f;
#pragma unroll
        for (int q = 0; q < 8; ++q) s += red[(q * 9 + r) * 64 + c];
        out[(size_t)r * ldo + col0 + c] = s + (bias ? bias[col0 + c] : 0.f); }
    __syncthreads();
}

__device__ __forceinline__ void transpose_item(const float* W, int K, int N, bf16_t* WT, LAS float* scr, int item, int lane, bool permw) {
    const int nblk = N / 32, kb = item / nblk, nb = item % nblk, k0 = 64 * kb, n0 = 32 * nb;
    int d0 = n0;
    if (permw) { const int T = n0 >> 8, w = (n0 >> 6) & 3, bj = (n0 >> 5) & 1; d0 = 256 * T + 128 * bj + 32 * w; }
    f32x4 v[8];
#pragma unroll
    for (int i = 0; i < 8; ++i) v[i] = *(const f32x4*)(W + (size_t)(k0 + 8 * i + (lane >> 3)) * N + n0 + 4 * (lane & 7));
#pragma unroll
    for (int i = 0; i < 8; ++i) { LAS float* d = scr + (8 * i + (lane >> 3)) * 33 + 4 * (lane & 7); d[0] = v[i][0]; d[1] = v[i][1]; d[2] = v[i][2]; d[3] = v[i][3]; }
    asm volatile("s_waitcnt lgkmcnt(0)" ::: "memory");
    const int c = lane & 7;
#pragma unroll
    for (int j = 0; j < 4; ++j) { const int n = (lane >> 3) + 8 * j; const LAS float* sp = scr + (8 * c) * 33 + n;
        u32x4 o; o.x = pk2(sp[0 * 33], sp[1 * 33]); o.y = pk2(sp[2 * 33], sp[3 * 33]); o.z = pk2(sp[4 * 33], sp[5 * 33]); o.w = pk2(sp[6 * 33], sp[7 * 33]);
        *(u32x4*)(WT + (size_t)(d0 + n) * K + k0 + 8 * c) = o; }
    asm volatile("s_waitcnt lgkmcnt(0)" ::: "memory");
}

#if DEBUG_ATTN
constexpr size_t WS_DBG = 3584 * 1024;
__device__ __forceinline__ void dbg_load64(const bf16_t* p, float (&x)[64]) {
#pragma unroll
    for (int c = 0; c < 8; ++c) { const u32x4 w = *(const u32x4*)(p + 8 * c);
        x[8 * c + 0] = bf_lo(w.x); x[8 * c + 1] = bf_hi(w.x); x[8 * c + 2] = bf_lo(w.y); x[8 * c + 3] = bf_hi(w.y); x[8 * c + 4] = bf_lo(w.z); x[8 * c + 5] = bf_hi(w.z); x[8 * c + 6] = bf_lo(w.w); x[8 * c + 7] = bf_hi(w.w); }
}
__device__ __forceinline__ float dbg_dot(const bf16_t* p, const float (&q)[64]) {
    float s = 0.f;
#pragma unroll
    for (int c = 0; c < 8; ++c) { const u32x4 w = *(const u32x4*)(p + 8 * c);
        s += q[8 * c + 0] * bf_lo(w.x) + q[8 * c + 1] * bf_hi(w.x) + q[8 * c + 2] * bf_lo(w.y) + q[8 * c + 3] * bf_hi(w.y) + q[8 * c + 4] * bf_lo(w.z) + q[8 * c + 5] * bf_hi(w.z) + q[8 * c + 6] * bf_lo(w.w) + q[8 * c + 7] * bf_hi(w.w); }
    return s;
}
__device__ __forceinline__ void dbg_task(int row, int h, int mix, const bf16_t* Qs, const bf16_t* Ofast, const bf16_t* Kb, const bf16_t* Vb, int kp, const float* nat_bias, float* acc, int lane) {
    const bool prompt = row < MP;
    const int b = prompt ? row / SEQP : (row - MP) / SEQS, t = prompt ? row % SEQP : (row - MP) % SEQS;
    const int hk = mix ? h : (h >> 2);
    float q[64]; dbg_load64(Qs + (size_t)row * 512 + h * 64, q);
    const size_t kvbase = prompt ? (size_t)NBS * KVL + (size_t)b * SEQP : (size_t)b * KVL;
    const int gr = t >> 6, gc = t & 63; int rs = gr - 4; rs = rs < 0 ? 0 : (rs > 56 ? 56 : rs); int cs = gc - 8; cs = cs < 0 ? 0 : (cs > 48 ? 48 : cs);
    const int nk = prompt ? SEQP : (mix ? PAST + 128 : KVL);
    float mx = -INFINITY;
    for (int i = lane; i < nk; i += 64) {
        int kr = i; float bias = 0.f;
        if (!prompt && mix && i >= PAST) { const int w = i - PAST, wr_ = w >> 4, wc_ = w & 15, krow = rs + wr_, kcol = cs + wc_; kr = PAST + krow * 64 + kcol;
            bias = nat_bias[(h * 15 + (krow - gr + 7)) * 31 + (kcol - gc + 15)] * LOG2E; }
        const float sc = dbg_dot(Kb + (kvbase + kr) * kp + hk * 64, q) + bias;
        mx = fmaxf(mx, sc);
    }
#pragma unroll
    for (int o = 1; o < 64; o <<= 1) mx = fmaxf(mx, __shfl_xor(mx, o));
    float l = 0.f; float ov[64];
#pragma unroll
    for (int d = 0; d < 64; ++d) ov[d] = 0.f;
    for (int i = lane; i < nk; i += 64) {
        int kr = i; float bias = 0.f;
        if (!prompt && mix && i >= PAST) { const int w = i - PAST, wr_ = w >> 4, wc_ = w & 15, krow = rs + wr_, kcol = cs + wc_; kr = PAST + krow * 64 + kcol;
            bias = nat_bias[(h * 15 + (krow - gr + 7)) * 31 + (kcol - gc + 15)] * LOG2E; }
        const float sc = dbg_dot(Kb + (kvbase + kr) * kp + hk * 64, q) + bias;
        const float pe = exp2f(sc - mx); l += pe;
        const bf16_t* vp = Vb + (kvbase + kr) * kp + hk * 64;
#pragma unroll
        for (int c = 0; c < 8; ++c) { const u32x4 w = *(const u32x4*)(vp + 8 * c);
            ov[8 * c + 0] += pe * bf_lo(w.x); ov[8 * c + 1] += pe * bf_hi(w.x); ov[8 * c + 2] += pe * bf_lo(w.y); ov[8 * c + 3] += pe * bf_hi(w.y); ov[8 * c + 4] += pe * bf_lo(w.z); ov[8 * c + 5] += pe * bf_hi(w.z); ov[8 * c + 6] += pe * bf_lo(w.w); ov[8 * c + 7] += pe * bf_hi(w.w); }
    }
    l = wave_sum(l); float mine = 0.f;
#pragma unroll
    for (int d = 0; d < 64; ++d) { const float tot = wave_sum(ov[d]); if (lane == d) mine = tot; }
    const float ref = mine / l;
    const bf16_t fo = Ofast[(size_t)row * 512 + h * 64 + lane]; const float fast = __uint_as_float((unsigned)fo << 16);
    const float df = fast - ref; const float sd = wave_sum(df * df), sr = wave_sum(ref * ref);
    const int cat = (prompt ? 0 : 2) + mix;
    if (lane == 0) { atomicAdd(acc + 2 * cat, sd); atomicAdd(acc + 2 * cat + 1, sr); }
}
#endif

#if DEBUG_ATTN
__device__ __forceinline__ void dbg_rope_task(int row, int h, int which, const float* xs, const float* mod, const float* n1g, const float* w_in, const float* qg, const float* kg,
                                              const bf16_t* Qs, const bf16_t* KAb, float* acc, LAS float* hs, int lane) {
    const int b = (row - MP) / SEQS, t = (row - MP) % SEQS;
    const float* xrow = xs + (size_t)(row - MP) * DM; const float* modr = mod + (size_t)b * NMOD;
    float xv[16]; float ss = 0.f;
#pragma unroll
    for (int j = 0; j < 16; ++j) { xv[j] = xrow[lane + 64 * j]; ss += xv[j] * xv[j]; }
    const float inv = 1.0f / sqrtf(wave_sum(ss) * (1.0f / DM) + RMS_EPS);
#pragma unroll
    for (int j = 0; j < 16; ++j) { const int c = lane + 64 * j; hs[c] = (xv[j] * inv) * n1g[c] * (1.0f + modr[1024 + c]) + modr[c]; }
    asm volatile("s_waitcnt lgkmcnt(0)" ::: "memory");
    const int col = (which ? 512 + h * 64 : h * 64) + lane;
    float val = 0.f;
    for (int k = 0; k < DM; ++k) val += hs[k] * w_in[(size_t)k * NIN + col];
    const float s2 = wave_sum(val * val);
    float v = val * (1.0f / sqrtf(s2 * (1.0f / 64.0f) + RMS_EPS)) * (which ? kg[lane] : qg[lane]);
    const int gr = t >> 6, gc = t & 63, i = lane & 15, pos = (lane & 32) ? gc : gr;
    const float invf = powf(10000.0f, -(float)i / 16.0f), ang = (float)pos * invf, co = cosf(ang), sn = sinf(ang);
    const float oth = __shfl_xor(v, 16);
    float o = (lane & 16) ? (oth * sn + v * co) : (v * co - oth * sn);
    if (!which) o *= C2;
    const bf16_t fb = which ? KAb[((size_t)b * KVL + PAST + t) * 128 + h * 64 + lane] : Qs[(size_t)row * 512 + h * 64 + lane];
    const float fast = __uint_as_float((unsigned)fb << 16), df = fast - o;
    const float sd = wave_sum(df * df), sr = wave_sum(o * o);
    if (lane == 0) { atomicAdd(acc + 2 * (4 + which), sd); atomicAdd(acc + 2 * (4 + which) + 1, sr); }
}
#endif

struct Args { const float* in[22]; float* out; unsigned char* ws; int ph_lo, ph_hi; };

__global__ void __launch_bounds__(NWAVES * 64, 2) fwd_kernel(Args args) {
    extern __shared__ __attribute__((aligned(16))) unsigned char lds[];
    Frame F;
    F.lds = (LAS unsigned char*)lds;
    F.tid = 0; F.lane = 0; F.wave = __builtin_amdgcn_readfirstlane(threadIdx.x >> 6);
    F.G = gridDim.x; { const int bx = blockIdx.x; F.vcu = (F.G % 8 == 0) ? (bx % 8) * (F.G / 8) + bx / 8 : bx; }
    XcdBarrier bar;
    {   volatile LAS unsigned* misc = (volatile LAS unsigned*)(F.lds + LDS_MISC);
        if (threadIdx.x < 2) misc[threadIdx.x] = 0u;
        __syncthreads();
        unsigned char* ws0 = (unsigned char*)(GAS unsigned char*)args.ws;
        bar = xcd_barrier_post((unsigned*)(ws0 + WS_BAR), misc);
    }
#define KARG(T, idx) ({ unsigned o_ = (unsigned)(idx) * 8u; asm volatile("" : "+s"(o_)); (T)(GAS void*)(*(const unsigned long long __attribute__((address_space(4)))*)((const char __attribute__((address_space(4)))*)__builtin_amdgcn_kernarg_segment_ptr() + o_)); })
#define IN_X_PROMPT 0
#define IN_X_SAMPLE 1
#define IN_CACHE_AK 2
#define IN_CACHE_AV 3
#define IN_CACHE_BK 4
#define IN_CACHE_BV 5
#define IN_C 6
#define IN_C_CTX 7
#define IN_W_MOD 8
#define IN_B_MOD 9
#define IN_N1G 10
#define IN_N2G 11
#define IN_W_IN 12
#define IN_QNG 13
#define IN_KNG 14
#define IN_NAT_BIAS 15
#define IN_W_BRA 16
#define IN_W_BRB 17
#define IN_W_OUT 18
#define IN_W_1 19
#define IN_W_2 20
#define IN_FNG 21
#define ARG_OUT 22
#define ARG_WS 23
#define WSP(T, off) ((T)(ws + (off)))
    unsigned long long pr_t0 = 0ull, pr_dt = 0ull;
#define PROBE_START(k) do { if (PROBE_LO == (k)) pr_t0 = __builtin_amdgcn_s_memrealtime(); } while (0)
#define PROBE_STOP(k) do { if (PROBE_HI == (k)) pr_dt = __builtin_amdgcn_s_memrealtime() - pr_t0; } while (0)
#define FRESH_TID() do { int t_ = threadIdx.x; asm volatile("" : "+v"(t_)); F.tid = t_; F.lane = t_ & 63; } while (0)
#if MK_PER_PHASE
    const int lo = args.ph_lo, hi = args.ph_hi;
#else
    constexpr int lo = 0, hi = NPHASE;
#endif
#define IN(k) (lo <= (k) && (k) < hi)
#define GRID_SYNC() do { asm volatile("s_waitcnt vmcnt(0) lgkmcnt(0)" ::: "memory"); xcd_barrier(bar); } while (0)
#define SEAM(k) do { if (IN(k) && IN((k) + 1)) GRID_SYNC(); } while (0)

    PROBE_START(0);
    if (IN(0)) {
        FRESH_TID();
        unsigned char* ws = KARG(unsigned char*, ARG_WS);
        const float* cvec = KARG(const float*, IN_C); const float* c_ctx = KARG(const float*, IN_C_CTX); const float* w_mod = KARG(const float*, IN_W_MOD); const float* b_mod = KARG(const float*, IN_B_MOD);
        const float* cache_ak = KARG(const float*, IN_CACHE_AK); const float* cache_av = KARG(const float*, IN_CACHE_AV); const float* cache_bk = KARG(const float*, IN_CACHE_BK); const float* cache_bv = KARG(const float*, IN_CACHE_BV);
        float* MOD = WSP(float*, WS_MOD); float* ROPEC = WSP(float*, WS_ROPE); float* ROPES = ROPEC + 1024;
        bf16_t* KA = WSP(bf16_t*, WS_KA); bf16_t* VA = WSP(bf16_t*, WS_VA); bf16_t* KB = WSP(bf16_t*, WS_KB); bf16_t* VB = WSP(bf16_t*, WS_VB);
#if DEBUG_ATTN
        if (blockIdx.x == 0 && F.tid < 16) WSP(float*, WS_DBG)[F.tid] = 0.f;
#endif
        LAS float* Sl = (LAS float*)F.lds; LAS float* red = (LAS float*)(F.lds + 49152);
        if ((int)blockIdx.x < 96) {
            for (int i = F.tid; i < 9 * 1024; i += 512) { const int r = i >> 10, k = i & 1023; const float v = (r < 8) ? cvec[r * 1024 + k] : c_ctx[k]; Sl[k * 12 + r] = v / (1.0f + expf(-v)); }
            __syncthreads();
            for (int it = blockIdx.x; it < 96; it += F.G) gemv9_item(Sl, red, w_mod, NMOD, it * 64, MOD, NMOD, b_mod, F.tid);
        }
        if ((int)blockIdx.x == F.G - 1) {
            for (int i = F.tid; i < 1024; i += 512) { const int pos = i >> 4, pi = i & 15;
                const float b4 = (pi & 3) == 0 ? 1.0f : ((pi & 3) == 1 ? 0.5623413251903491f : ((pi & 3) == 2 ? 0.31622776601683794f : 0.1778279410038923f));
                const float d4 = (pi >> 2) == 0 ? 1.0f : ((pi >> 2) == 1 ? 0.1f : ((pi >> 2) == 2 ? 0.01f : 0.001f));
                const float ang = (float)pos * (b4 * d4);
                const float kq = rintf(ang * 0.15915494309189535f);
                float r = fmaf(-kq, 6.2831854820251465f, ang); r = fmaf(-kq, -1.7484555e-7f, r);
                ROPEC[i] = cosf(r); ROPES[i] = sinf(r); }
        }
        { const int gt = F.vcu * 512 + F.tid, NT_ = F.G * 512;
          for (int e = gt; e < 2 * 131072; e += NT_) {
              const int which = e >= 131072; const int q = which ? e - 131072 : e; const int b = q >> 14, p = (q >> 5) & 511, c4 = q & 31;
              const f32x4 v = *(const f32x4*)((which ? cache_av : cache_ak) + (size_t)q * 4);
              u32x2 w; w.x = pk2(v[0], v[1]); w.y = pk2(v[2], v[3]);
              *(u32x2*)((which ? VA : KA) + ((size_t)(b * KVL + p)) * 128 + c4 * 4) = w; }
          for (int e = gt; e < 2 * 524288; e += NT_) {
              const int which = e >= 524288; const int q = which ? e - 524288 : e; const int b = q >> 16, p = (q >> 7) & 511, c4 = q & 127;
              const f32x4 v = *(const f32x4*)((which ? cache_bv : cache_bk) + (size_t)q * 4);
              u32x2 w; w.x = pk2(v[0], v[1]); w.y = pk2(v[2], v[3]);
              *(u32x2*)((which ? VB : KB) + ((size_t)(b * KVL + p)) * 512 + c4 * 4) = w; } }
    }
    SEAM(0);
    PROBE_STOP(0);

    PROBE_START(1);
    if (IN(1)) {
        FRESH_TID();
        unsigned char* ws = KARG(unsigned char*, ARG_WS);
        const float* x_prompt = KARG(const float*, IN_X_PROMPT); const float* x_sample = KARG(const float*, IN_X_SAMPLE); const float* n1g = KARG(const float*, IN_N1G);
        const float* w_in = KARG(const float*, IN_W_IN); const float* w_bra = KARG(const float*, IN_W_BRA); const float* w_brb = KARG(const float*, IN_W_BRB); const float* w_out = KARG(const float*, IN_W_OUT);
        const float* w_1 = KARG(const float*, IN_W_1); const float* w_2 = KARG(const float*, IN_W_2);
        float* MOD = WSP(float*, WS_MOD); float* BUP = WSP(float*, WS_BUP); bf16_t* Hb = WSP(bf16_t*, WS_H);
        bf16_t* WIN_t = WSP(bf16_t*, WS_WIN); bf16_t* WBRA_t = WSP(bf16_t*, WS_WBRA); bf16_t* WBRB_t = WSP(bf16_t*, WS_WBRB); bf16_t* WOUT_t = WSP(bf16_t*, WS_WOUT); bf16_t* W1_t = WSP(bf16_t*, WS_W1); bf16_t* W2_t = WSP(bf16_t*, WS_W2);
        if ((int)blockIdx.x < 64) {
            LAS float* Sl = (LAS float*)F.lds; LAS float* red = (LAS float*)(F.lds + 49152);
            for (int i = F.tid; i < 9 * 1024; i += 512) { const int r = i >> 10, k = i & 1023; Sl[k * 12 + r] = MOD[(size_t)r * NMOD + 3072 + k]; }
            __syncthreads();
            for (int it = blockIdx.x; it < 64; it += F.G) gemv9_item(Sl, red, w_1, FF, it * 64, BUP, FF, nullptr, F.tid);
        }
        LAS float* scr = (LAS float*)(F.lds + F.wave * 16384);
        const int gw = F.vcu * NWAVES + F.wave, NGW = F.G * NWAVES;
        constexpr int I_IN = (DM / 64) * (NIN / 32), I_BR = (512 / 64) * (DM / 32), I_O = (DM / 64) * (DM / 32), I_1 = (DM / 64) * (FF / 32), I_2 = (FF / 64) * (DM / 32);
        constexpr int NITEMS = I_IN + 2 * I_BR + I_O + I_1 + I_2;
        for (int it = gw; it < NITEMS; it += NGW) {
            int r = it;
            if (r < I_IN) { transpose_item(w_in, DM, NIN, WIN_t, scr, r, F.lane, true); continue; } r -= I_IN;
            if (r < I_BR) { transpose_item(w_bra, 512, DM, WBRA_t, scr, r, F.lane, false); continue; } r -= I_BR;
            if (r < I_BR) { transpose_item(w_brb, 512, DM, WBRB_t, scr, r, F.lane, false); continue; } r -= I_BR;
            if (r < I_O) { transpose_item(w_out, DM, DM, WOUT_t, scr, r, F.lane, false); continue; } r -= I_O;
            if (r < I_1) { transpose_item(w_1, DM, FF, W1_t, scr, r, F.lane, false); continue; } r -= I_1;
            transpose_item(w_2, FF, DM, W2_t, scr, r, F.lane, false);
        }
        for (int m0 = gw * 4; m0 < M; m0 += NGW * 4) {
            const float* xrow0 = (m0 < MP) ? x_prompt + (size_t)m0 * DM : x_sample + (size_t)(m0 - MP) * DM;
            const int mrow = (m0 < MP) ? 8 : ((m0 - MP) >> 12);
            const float* modr = MOD + (size_t)mrow * NMOD;
            f32x4 v[4][4]; float s[4];
#pragma unroll
            for (int r = 0; r < 4; ++r)
#pragma unroll
                for (int j = 0; j < 4; ++j) v[r][j] = ((const f32x4*)(xrow0 + (size_t)r * DM))[F.lane + 64 * j];
#pragma unroll
            for (int r = 0; r < 4; ++r) { s[r] = 0.f;
#pragma unroll
                for (int j = 0; j < 4; ++j) s[r] += (v[r][j][0] * v[r][j][0] + v[r][j][1] * v[r][j][1]) + (v[r][j][2] * v[r][j][2] + v[r][j][3] * v[r][j][3]); }
#pragma unroll
            for (int o = 1; o < 64; o <<= 1) {
#pragma unroll
                for (int r = 0; r < 4; ++r) s[r] += __shfl_xor(s[r], o); }
#pragma unroll
            for (int j = 0; j < 4; ++j) { const int c = 4 * F.lane + 256 * j;
                const f32x4 g = *(const f32x4*)(n1g + c), sc = *(const f32x4*)(modr + 1024 + c), sh = *(const f32x4*)(modr + c);
                const f32x4 gs = g * (sc + 1.0f);
#pragma unroll
                for (int r = 0; r < 4; ++r) { const float inv = 1.0f / sqrtf(s[r] * (1.0f / DM) + RMS_EPS);
                    const f32x4 h = ((v[r][j] * inv) * g) * (sc + 1.0f) + sh;
                    ((unsigned long long*)(Hb + (size_t)(m0 + r) * DM))[F.lane + 64 * j] = (unsigned long long)pk2(h[0], h[1]) | ((unsigned long long)pk2(h[2], h[3]) << 32); }
                (void)gs; }
        }
    }
    SEAM(1);
    PROBE_STOP(1);

    PROBE_START(2);
    if (IN(2)) {
        unsigned char* ws = KARG(unsigned char*, ARG_WS); float* out = KARG(float*, ARG_OUT); const float* qng = KARG(const float*, IN_QNG); const float* kng = KARG(const float*, IN_KNG);
        OpsPlain P{(const char*)(ws + WS_H), (const char*)(ws + WS_WIN), (size_t)256 * DM * 2};
        pg8::StaticOrder S; S.init(M, NIN, F.G, (int)blockIdx.x);
        EpiIn E{ws, out, qng, kng};
        pg8::gemm_phase<EpiIn, pg8::StaticOrder, OpsPlain>(F.lds, P, DM, S, E);
    }
    SEAM(2);
    PROBE_STOP(2);

    PROBE_START(3);
    if (IN(3)) {
        using namespace attn_body;
        FRESH_TID();
        unsigned char* ws = KARG(unsigned char*, ARG_WS); const float* nat_bias = KARG(const float*, IN_NAT_BIAS);
        bf16_t* QA = WSP(bf16_t*, WS_QA); bf16_t* QB = WSP(bf16_t*, WS_QB); bf16_t* KA = WSP(bf16_t*, WS_KA); bf16_t* VA = WSP(bf16_t*, WS_VA); bf16_t* KB = WSP(bf16_t*, WS_KB); bf16_t* VB = WSP(bf16_t*, WS_VB);
        char* shm = (char*)lds;
#if DEBUG_ATTN
        {
            const u32x4* src = (const u32x4*)QA; u32x4* dstq = (u32x4*)(ws + WS_H); const size_t n16 = (size_t)M * 512 * 2 * 2 / 16;
            for (size_t e = (size_t)F.vcu * 512 + F.tid; e < n16; e += (size_t)F.G * 512) dstq[e] = src[e];
            GRID_SYNC();
        }
#endif
        const int x = F.vcu >> 5, j = F.vcu & 31;
        if (F.G == 256) {
            { LAS float* mw = (LAS float*)(F.lds + LDS_MASK);
              for (int e = F.tid; e < 65 * MSKR; e += 512) { const int qc_ = e / MSKR, kc_ = e - qc_ * MSKR; int cs = qc_ - 8; cs = cs < 0 ? 0 : (cs > 48 ? 48 : cs); mw[e] = (qc_ < 64 && kc_ >= cs && kc_ < cs + 16) ? 0.f : -INFINITY; } }
            for (int i = 0; i < 4; ++i) {
                const int uu = i * 32 + j, grp = 2 * x + (uu >> 6), b = grp >> 1, kvh = grp & 1, h = kvh * 4 + ((uu & 63) >> 4), qb = uu & 15;
                const size_t row0 = (size_t)MP + (size_t)b * SEQS + (size_t)qb * 256;
                AttnDesc d; d.Qw0 = (const bf16*)QA + row0 * 512 + h * 64; d.Ow0 = (bf16*)QA + row0 * 512 + h * 64;
                d.Kh = (const bf16*)KA + (size_t)b * KVL * 128 + kvh * 64; d.Vh = (const bf16*)VA + (size_t)b * KVL * 128 + kvh * 64;
                d.qp = 512; d.kp = 128; d.NT = KVL / 64; d.lo = 0; d.qrow0 = 0;
                attn_unit<0, 8>(d, shm);
            }
            for (int i = 0; i < 4; ++i) {
                const int uu = i * 32 + j, pr = 8 * x + (uu >> 4), b = pr >> 3, h = pr & 7, qb = uu & 15;
                const size_t row0 = (size_t)MP + (size_t)b * SEQS + (size_t)qb * 256;
                { LAS float* tabw = (LAS float*)(F.lds + LDS_TAB);
                  for (int e = F.tid; e < 4 * 16 * 132; e += 512) { const int sc = e / 2112, rem = e - sc * 2112, dr = rem / 132, jj = rem - dr * 132, df = jj - sc - 64;
                      tabw[sc * (TABC + 1) - sc + dr * TABR + jj] = (dr < 15 && df >= -15 && df <= 15) ? nat_bias[(h * 15 + dr) * 31 + df + 15] * LOG2E : 0.f; }
                  asm volatile("s_waitcnt vmcnt(0) lgkmcnt(0)\n\ts_barrier" ::: "memory"); }
                int lo_ = 4 * qb - 4; lo_ = lo_ < 0 ? 0 : lo_; int nloc = (qb == 0 || qb == 15) ? 8 : 12; if (qb == 15) lo_ = 56; if (lo_ > 64 - nloc) lo_ = 64 - nloc;
                AttnDesc d; d.Qw0 = (const bf16*)QB + row0 * 512 + h * 64; d.Ow0 = (bf16*)QB + row0 * 512 + h * 64;
                d.Kh = (const bf16*)KB + (size_t)b * KVL * 512 + h * 64; d.Vh = (const bf16*)VB + (size_t)b * KVL * 512 + h * 64;
                d.qp = 512; d.kp = 512; d.NT = 8 + nloc; d.lo = lo_; d.qrow0 = 4 * qb;
                attn_unit<1, 8>(d, shm);
            }
            for (int i = 0; i < 2; ++i) {
                const int uu = i * 32 + j, b = 4 * x + (uu >> 4), hh = uu & 15;
                const size_t row0 = (size_t)b * SEQP, kv0 = (size_t)NBS * KVL + (size_t)b * SEQP;
                AttnDesc d; d.NT = 4; d.lo = 0; d.qrow0 = 0; d.qp = 512;
                if (hh < 8) { d.Qw0 = (const bf16*)QA + row0 * 512 + hh * 64; d.Ow0 = (bf16*)QA + row0 * 512 + hh * 64;
                    d.Kh = (const bf16*)KA + kv0 * 128 + (hh >> 2) * 64; d.Vh = (const bf16*)VA + kv0 * 128 + (hh >> 2) * 64; d.kp = 128; }
                else { const int h = hh - 8; d.Qw0 = (const bf16*)QB + row0 * 512 + h * 64; d.Ow0 = (bf16*)QB + row0 * 512 + h * 64;
                    d.Kh = (const bf16*)KB + kv0 * 512 + h * 64; d.Vh = (const bf16*)VB + kv0 * 512 + h * 64; d.kp = 512; }
                attn_unit<0, 8>(d, shm);
            }
        }
    }
    SEAM(3);
    PROBE_STOP(3);
#if DEBUG_ATTN
    {
        FRESH_TID();
        unsigned char* ws = KARG(unsigned char*, ARG_WS); const float* nat_bias = KARG(const float*, IN_NAT_BIAS);
        const bf16_t* QAs = WSP(const bf16_t*, WS_H); const bf16_t* QBs = WSP(const bf16_t*, WS_H + 40 * MiB);
        const int gw = F.vcu * NWAVES + F.wave;
        for (int jt = 0; jt < 8; ++jt) {
            const unsigned hsh = (unsigned)(gw * 8 + jt) * 2654435761u;
            const int mix = jt & 1, prm = (jt >> 1) & 1, h = (hsh >> 8) & 7;
            int row;
            if (prm) row = (int)((hsh >> 12) % MP);
            else { const int b = (hsh >> 11) & 7; int t;
                if (jt & 4) { const int er = (hsh >> 14) & 7, ec = (hsh >> 17) % 11;
                    const int rr = er == 0 ? 0 : er == 1 ? 1 : er == 2 ? 3 : er == 3 ? 4 : er == 4 ? 5 : er == 5 ? 59 : er == 6 ? 60 : 63;
                    const int cc = ec == 0 ? 0 : ec == 1 ? 1 : ec == 2 ? 7 : ec == 3 ? 8 : ec == 4 ? 9 : ec == 5 ? 31 : ec == 6 ? 32 : ec == 7 ? 55 : ec == 8 ? 56 : ec == 9 ? 57 : 63;
                    t = rr * 64 + cc; }
                else t = (hsh >> 14) % SEQS;
                row = MP + b * SEQS + t; }
            if (mix == 0) dbg_task(row, h, 0, QAs, WSP(const bf16_t*, WS_QA), WSP(const bf16_t*, WS_KA), WSP(const bf16_t*, WS_VA), 128, nat_bias, WSP(float*, WS_DBG), F.lane);
            else dbg_task(row, h, 1, QBs, WSP(const bf16_t*, WS_QB), WSP(const bf16_t*, WS_KB), WSP(const bf16_t*, WS_VB), 512, nat_bias, WSP(float*, WS_DBG), F.lane);
        }
        {   const float* xs_ = KARG(const float*, IN_X_SAMPLE); const float* n1g_ = KARG(const float*, IN_N1G); const float* w_in_ = KARG(const float*, IN_W_IN);
            const float* qg_ = KARG(const float*, IN_QNG); const float* kg_ = KARG(const float*, IN_KNG);
            LAS float* hs = (LAS float*)(F.lds + F.wave * 4096);
            for (int jt = 0; jt < 2; ++jt) {
                const unsigned hsh = (unsigned)(gw * 2 + jt + 77777) * 2654435761u;
                const int b = (hsh >> 11) & 7, t = (hsh >> 14) % SEQS, row = MP + b * SEQS + t;
                dbg_rope_task(row, jt ? ((hsh >> 8) & 1) : ((hsh >> 8) & 7), jt, xs_, WSP(const float*, WS_MOD), n1g_, w_in_, qg_, kg_, QAs, WSP(const bf16_t*, WS_KA), WSP(float*, WS_DBG), hs, F.lane);
            }
        }
        GRID_SYNC();
    }
#endif

    PROBE_START(4);
    if (IN(4)) {
        unsigned char* ws = KARG(unsigned char*, ARG_WS);
        OpsPair P{(const char*)(ws + WS_QA), (long)(WS_QB - WS_QA), (const char*)(ws + WS_WBRA), (long)(WS_WBRB - WS_WBRA), (size_t)256 * 512 * 2};
        pg8::PairOrder S; S.init(M, DM, F.G, (int)blockIdx.x);
        EpiBr E{WSP(const bf16_t*, WS_GA), WSP(const bf16_t*, WS_GB), WSP(bf16_t*, WS_MM)};
        pg8::gemm_phase<EpiBr, pg8::PairOrder, OpsPair>(F.lds, P, 512, S, E, STAG_P4);
    }
    SEAM(4);
    PROBE_STOP(4);

    PROBE_START(5);
    if (IN(5)) {
        unsigned char* ws = KARG(unsigned char*, ARG_WS); float* out = KARG(float*, ARG_OUT);
        const float* x_prompt = KARG(const float*, IN_X_PROMPT); const float* x_sample = KARG(const float*, IN_X_SAMPLE); const float* n2g = KARG(const float*, IN_N2G);
        OpsPlain P{(const char*)(ws + WS_MM), (const char*)(ws + WS_WOUT), (size_t)256 * DM * 2};
        pg8::StaticOrder S; S.init(M, DM, F.G, (int)blockIdx.x);
        EpiOut E{x_prompt, x_sample, WSP(const float*, WS_MOD), n2g, out + OUT_Y, WSP(bf16_t*, WS_XW), WSP(float*, WS_SSQ)};
        pg8::gemm_phase<EpiOut, pg8::StaticOrder, OpsPlain>(F.lds, P, DM, S, E, STAG_P5);
    }
    SEAM(5);
    PROBE_STOP(5);

    PROBE_START(6);
    if (IN(6)) {
        unsigned char* ws = KARG(unsigned char*, ARG_WS);
        OpsPlain P{(const char*)(ws + WS_XW), (const char*)(ws + WS_W1), (size_t)256 * DM * 2};
        pg8::StaticOrder S; S.init(M, FF, F.G, (int)blockIdx.x);
        EpiUp E{WSP(const float*, WS_SSQ), WSP(const float*, WS_BUP), WSP(bf16_t*, WS_HID)};
        pg8::gemm_phase<EpiUp, pg8::StaticOrder, OpsPlain>(F.lds, P, DM, S, E);
    }
    SEAM(6);
    PROBE_STOP(6);

    PROBE_START(7);
    if (IN(7)) {
        unsigned char* ws = KARG(unsigned char*, ARG_WS); float* out = KARG(float*, ARG_OUT);
        OpsPlain P{(const char*)(ws + WS_HID), (const char*)(ws + WS_W2), (size_t)256 * FF * 2};
        pg8::StaticOrder S; S.init(M, DM, F.G, (int)blockIdx.x);
        EpiDown E{WSP(const float*, WS_MOD), out + OUT_Y};
        pg8::gemm_phase<EpiDown, pg8::StaticOrder, OpsPlain>(F.lds, P, FF, S, E, STAG_P7);
    }
    SEAM(7);
    PROBE_STOP(7);

    PROBE_START(8);
    if (IN(8)) {
        FRESH_TID();
        float* out = KARG(float*, ARG_OUT); const float* fng = KARG(const float*, IN_FNG);
        const int gw = F.vcu * NWAVES + F.wave, NGW = F.G * NWAVES;
        for (int m0 = gw * 4; m0 < M; m0 += NGW * 4) {
            f32x4* xr = (f32x4*)(out + OUT_Y + (size_t)m0 * DM) + F.lane;
            f32x4 v[4][4]; float s[4];
#pragma unroll
            for (int r = 0; r < 4; ++r)
#pragma unroll
                for (int j = 0; j < 4; ++j) v[r][j] = xr[r * (DM / 4) + 64 * j];
#pragma unroll
            for (int r = 0; r < 4; ++r) { s[r] = 0.f;
#pragma unroll
                for (int j = 0; j < 4; ++j) s[r] += (v[r][j][0] * v[r][j][0] + v[r][j][1] * v[r][j][1]) + (v[r][j][2] * v[r][j][2] + v[r][j][3] * v[r][j][3]); }
#pragma unroll
            for (int o = 1; o < 64; o <<= 1) {
#pragma unroll
                for (int r = 0; r < 4; ++r) s[r] += __shfl_xor(s[r], o); }
#pragma unroll
            for (int j = 0; j < 4; ++j) { const f32x4 g = *(const f32x4*)(fng + 4 * F.lane + 256 * j);
#pragma unroll
                for (int r = 0; r < 4; ++r) { const float inv = 1.0f / sqrtf(s[r] * (1.0f / DM) + RMS_EPS); xr[r * (DM / 4) + 64 * j] = (v[r][j] * inv) * g; } }
        }
    }
    PROBE_STOP(8);
    if (PROBE_LO >= 0 && blockIdx.x == 0) { const unsigned long long te = __builtin_amdgcn_s_memrealtime(); while (__builtin_amdgcn_s_memrealtime() - te < PROBE_MULT * pr_dt) __builtin_amdgcn_s_sleep(16); }
#undef IN
#undef SEAM
}

extern "C" void kernel_launch(void* const* d_in, const int* in_sizes, int n_in, void* d_out, int out_size, void* d_ws, size_t ws_size, hipStream_t stream) {
    static int grid = 0;
    if (grid == 0) {
        if (n_in != 22 || ws_size < WS_END) { fprintf(stderr, "kernel_launch: unexpected problem (n_in %d, ws %zu)\n", n_in, ws_size); grid = -1; return; }
        int dev = 0, cus = 0, per_cu = 0;
        if (hipGetDevice(&dev) != hipSuccess || hipDeviceGetAttribute(&cus, hipDeviceAttributeMultiprocessorCount, dev) != hipSuccess) { grid = -1; return; }
        if (hipFuncSetAttribute((const void*)fwd_kernel, hipFuncAttributeMaxDynamicSharedMemorySize, LDS_BYTES) != hipSuccess) { fprintf(stderr, "kernel_launch: hipFuncSetAttribute failed\n"); grid = -1; return; }
        if (hipOccupancyMaxActiveBlocksPerMultiprocessor(&per_cu, (const void*)fwd_kernel, NWAVES * 64, LDS_BYTES) != hipSuccess || per_cu < 1) { fprintf(stderr, "kernel_launch: occupancy query says %d\n", per_cu); (void)hipGetLastError(); per_cu = 1; }
        grid = cus;
        if (grid != 256) fprintf(stderr, "kernel_launch: %d CUs; the attention phase is dealt for 256\n", grid);
    }
    if (grid < 0) return;
    Args a{};
    for (int i = 0; i < 22; ++i) a.in[i] = (const float*)d_in[i];
    a.out = (float*)d_out; a.ws = (unsigned char*)d_ws;
#if MK_PER_PHASE
    for (int p = 0; p < NPHASE; ++p) { a.ph_lo = p; a.ph_hi = p + 1; hipLaunchKernelGGL(fwd_kernel, dim3(grid), dim3(NWAVES * 64), LDS_BYTES, stream, a); }
#else
    a.ph_lo = 0; a.ph_hi = NPHASE;
    if (hipMemsetAsync((char*)d_ws + WS_BAR, 0, 16384, stream) != hipSuccess) { fprintf(stderr, "kernel_launch: memset of the barrier words failed\n"); return; }
    hipLaunchKernelGGL(fwd_kernel, dim3(grid), dim3(NWAVES * 64), LDS_BYTES, stream, a);
    if (hipPeekAtLastError() != hipSuccess) fprintf(stderr, "kernel_launch: launch failed\n");
#endif
}
```
